# Optimizing an MI355X kernel written in HIP

```python
import math
import jax
import jax.numpy as jnp
from jax import lax
import numpy as np

D_MODEL = 1024
BATCH = 8
SEQ = 4096
DEPTH = 4

GRID_W = 64
CTX_LEN = 256
N_MIXERS = 3
Q_BLOCK = 128
ROPE_THETA = 10000.0
NORM_EPS = 1e-6
N_MOD = 9
D_FF = 2816

DA_HEADS = 8
DA_HEAD_DIM = D_MODEL // (2 * DA_HEADS)
GQ_HEADS = 8
GQ_KV_HEADS = 2
GQ_HEAD_DIM = D_MODEL // GQ_HEADS
GQ_GROUP = GQ_HEADS // GQ_KV_HEADS
GQ_QKV = (GQ_HEADS + 2 * GQ_KV_HEADS) * GQ_HEAD_DIM
RW_HEAD = 64
RW_HEADS = D_MODEL // RW_HEAD
RW_DECAY_LORA = 64
RW_AAA_LORA = 64
RW_GATE_LORA = 128
RW_GN_EPS = 64e-5

kernel_name = "hybrid_dit_diffattn_gqa_rwkv7_macaron"


def rms_norm(x, gain=None):
    xf = x.astype(jnp.float32)
    y = xf * lax.rsqrt(jnp.mean(xf * xf, axis=-1, keepdims=True) + NORM_EPS)
    if gain is not None:
        y = y * gain.astype(jnp.float32)
    return y.astype(x.dtype)


def modulate(h, shift, scale):
    return rms_norm(h) * (1 + scale) + shift


def swiglu(x, wg, wu, wd):
    return (jax.nn.silu(x @ wg) * (x @ wu)) @ wd


def axial_rope(n_tokens, head_dim, dtype):
    rows = n_tokens // GRID_W
    row = jnp.repeat(jnp.arange(rows, dtype=jnp.int32), GRID_W).astype(jnp.float32)
    col = jnp.tile(jnp.arange(GRID_W, dtype=jnp.int32), rows).astype(jnp.float32)
    n_freq = head_dim // 4
    inv = jnp.power(ROPE_THETA, -jnp.arange(n_freq, dtype=jnp.float32) / n_freq)
    ang = jnp.concatenate([row[:, None] * inv, col[:, None] * inv], axis=-1)
    return jnp.cos(ang).astype(dtype), jnp.sin(ang).astype(dtype)


def apply_rope(x, cos, sin):
    shape = (cos.shape[0],) + (1,) * (x.ndim - 3) + (cos.shape[-1],)
    cos = cos.reshape(shape)
    sin = sin.reshape(shape)
    x1, x2 = jnp.split(x, 2, axis=-1)
    return jnp.concatenate([x1 * cos - x2 * sin, x2 * cos + x1 * sin], axis=-1)


def sweep_query_blocks(fn, q):
    b, s = q.shape[:2]
    nb = s // Q_BLOCK
    qb = jnp.moveaxis(q.reshape((b, nb, Q_BLOCK) + q.shape[2:]), 1, 0)
    out = jnp.moveaxis(lax.map(fn, qb), 0, 1)
    return out.reshape((b, s) + out.shape[3:])


def diff_attn_core(q, k, v, lam):
    s = jnp.einsum('bqhcd,bkhcd->bhcqk', q, k, preferred_element_type=jnp.float32) * (DA_HEAD_DIM ** -0.5)
    p = jax.nn.softmax(s, axis=-1)
    a = p[:, :, 0] - lam * p[:, :, 1]
    return jnp.einsum('bhqk,bkhe->bqhe', a.astype(v.dtype), v)


def differential_attention(u, uc, wqkv, wo, lam_vecs, subln_g, lam_init, need_ctx):
    b, s, _ = u.shape

    def project(z):
        t = z.shape[1]
        q, k, v = jnp.split(z @ wqkv, 3, axis=-1)
        return (q.reshape(b, t, DA_HEADS, 2, DA_HEAD_DIM),
                k.reshape(b, t, DA_HEADS, 2, DA_HEAD_DIM),
                v.reshape(b, t, DA_HEADS, 2 * DA_HEAD_DIM))

    q, k, v = project(u)
    qc, kc, vc = project(uc)
    cos, sin = axial_rope(s, DA_HEAD_DIM, u.dtype)
    q = apply_rope(q, cos, sin)
    k = apply_rope(k, cos, sin)
    lv = lam_vecs.astype(jnp.float32)
    lam = jnp.exp(jnp.sum(lv[0] * lv[1])) - jnp.exp(jnp.sum(lv[2] * lv[3])) + lam_init
    k_all = jnp.concatenate([kc, k], axis=1)
    v_all = jnp.concatenate([vc, v], axis=1)

    def finish(o):
        o = rms_norm(o, subln_g) * (1.0 - lam_init)
        return o.reshape(o.shape[0], o.shape[1], D_MODEL) @ wo

    y = finish(sweep_query_blocks(lambda qb: diff_attn_core(qb, k_all, v_all, lam), q))
    yc = finish(diff_attn_core(qc, kc, vc, lam)) if need_ctx else None
    return y, yc


def gqa_core(q, k, v):
    s = jnp.einsum('bqgmd,bkgd->bgmqk', q, k, preferred_element_type=jnp.float32) * (GQ_HEAD_DIM ** -0.5)
    p = jax.nn.softmax(s, axis=-1)
    return jnp.einsum('bgmqk,bkgd->bqgmd', p.astype(v.dtype), v)


def grouped_query_attention(u, uc, wqkv, wo, qk_g, need_ctx):
    b, s, _ = u.shape
    nq = GQ_HEADS * GQ_HEAD_DIM
    nk = GQ_KV_HEADS * GQ_HEAD_DIM

    def project(z):
        t = z.shape[1]
        qkv = z @ wqkv
        q = qkv[..., :nq].reshape(b, t, GQ_KV_HEADS, GQ_GROUP, GQ_HEAD_DIM)
        k = qkv[..., nq:nq + nk].reshape(b, t, GQ_KV_HEADS, GQ_HEAD_DIM)
        v = qkv[..., nq + nk:].reshape(b, t, GQ_KV_HEADS, GQ_HEAD_DIM)
        return rms_norm(q, qk_g[0]), rms_norm(k, qk_g[1]), v

    q, k, v = project(u)
    qc, kc, vc = project(uc)
    cos, sin = axial_rope(s, GQ_HEAD_DIM, u.dtype)
    q = apply_rope(q, cos, sin)
    k = apply_rope(k, cos, sin)
    k_all = jnp.concatenate([kc, k], axis=1)
    v_all = jnp.concatenate([vc, v], axis=1)

    def finish(o):
        return o.reshape(o.shape[0], o.shape[1], D_MODEL) @ wo

    y = finish(sweep_query_blocks(lambda qb: gqa_core(qb, k_all, v_all), q))
    yc = finish(gqa_core(qc, kc, vc)) if need_ctx else None
    return y, yc


def rwkv_token_inputs(z, mu, wr, wk, wv, w0, w1, w2, a0, a1, a2, g1, g2, k_k, k_a, r_k):
    b, t, _ = z.shape
    zero = jnp.zeros_like(z[:, :1])
    d_prev = jnp.concatenate([zero, z[:, :-1]], axis=1) - z
    d_next = jnp.concatenate([z[:, 1:], zero], axis=1) - z

    def mix(i):
        return z + d_prev * mu[0, i] + d_next * mu[1, i]

    def heads(y):
        return y.reshape(b, t, RW_HEADS, RW_HEAD)

    xw, xa, xg = mix(1), mix(4), mix(5)
    r = heads(mix(0) @ wr)
    k = mix(2) @ wk
    v = heads(mix(3) @ wv)
    dirs = []
    for d in range(2):
        w_log = -jax.nn.softplus(-(w0[d] + jnp.tanh(xw @ w1[d]) @ w2[d])) - 0.5
        decay = jnp.exp(-jnp.exp(w_log.astype(jnp.float32)))
        a = jax.nn.sigmoid(a0[d] + (xa @ a1[d]) @ a2[d])
        g = jax.nn.sigmoid(xg @ g1[d]) @ g2[d]
        kk = heads(k * k_k[d]).astype(jnp.float32)
        kk = kk / jnp.maximum(jnp.linalg.norm(kk, axis=-1, keepdims=True), 1e-12)
        kd = heads(k * (1 + (a - 1) * k_a[d]))
        bonus = jnp.sum((r * kd * r_k[d]).astype(jnp.float32), axis=-1, keepdims=True) * v.astype(jnp.float32)
        dirs.append((heads(decay), kd, -kk, kk * heads(a).astype(jnp.float32), g, bonus))
    return r, v, dirs


def wkv7_scan(state, r, decay, k, v, a, b, reverse):
    xs = tuple(jnp.moveaxis(z.astype(jnp.float32), 1, 0) for z in (r, decay, k, v, a, b))

    def step(S, inp):
        r_t, w_t, k_t, v_t, a_t, b_t = inp
        sa = jnp.einsum('bhvk,bhk->bhv', S, a_t)
        S = S * w_t[:, :, None, :] + sa[..., None] * b_t[:, :, None, :] + v_t[..., None] * k_t[:, :, None, :]
        return S, jnp.einsum('bhvk,bhk->bhv', S, r_t)

    state, ys = lax.scan(step, state, xs, reverse=reverse)
    return state, jnp.moveaxis(ys, 0, 1)


def rwkv_readout(y, bonus, g, ln_g, ln_b, dtype):
    b, t = y.shape[:2]
    mean = jnp.mean(y, axis=-1, keepdims=True)
    var = jnp.mean(jnp.square(y - mean), axis=-1, keepdims=True)
    yn = ((y - mean) * lax.rsqrt(var + RW_GN_EPS)).reshape(b, t, D_MODEL)
    out = yn * ln_g.astype(jnp.float32) + ln_b.astype(jnp.float32) + bonus.reshape(b, t, D_MODEL)
    return out.astype(dtype) * g


def rwkv7_bidirectional(u, uc, mu, wr, wk, wv, wo, w0, w1, w2, a0, a1, a2, g1, g2, k_k, k_a, r_k,
                        ln_g, ln_b, need_ctx):
    params = (mu, wr, wk, wv, w0, w1, w2, a0, a1, a2, g1, g2, k_k, k_a, r_k)
    r, v, dirs = rwkv_token_inputs(u, *params)
    rc, vc, dirs_c = rwkv_token_inputs(uc, *params)
    state0 = jnp.zeros((u.shape[0], RW_HEADS, RW_HEAD, RW_HEAD), jnp.float32)
    outs, outs_c = [], []
    for d in range(2):
        reverse = d == 1
        dc, kdc, ac, bc, gc, bonc = dirs_c[d]
        dl, kdl, al, bl, gl, bonl = dirs[d]
        state_c, wkv_c = wkv7_scan(state0, rc, dc, kdc, vc, ac, bc, reverse)
        _, wkv_l = wkv7_scan(state_c, r, dl, kdl, v, al, bl, reverse)
        outs.append(rwkv_readout(wkv_l, bonl, gl, ln_g[d], ln_b[d], u.dtype))
        if need_ctx:
            outs_c.append(rwkv_readout(wkv_c, bonc, gc, ln_g[d], ln_b[d], u.dtype))
    y = (outs[0] + outs[1]) @ wo
    yc = (outs_c[0] + outs_c[1]) @ wo if need_ctx else None
    return y, yc


def setup_inputs(seed: int = 0) -> dict:
    key = jax.random.key(seed)
    ks = iter(jax.random.split(key, 48))
    D = D_MODEL
    n_a = (DEPTH + 2) // N_MIXERS
    n_b = (DEPTH + 1) // N_MIXERS
    n_c = DEPTH // N_MIXERS

    def nrm(shape, scale):
        return jax.random.normal(next(ks), shape, jnp.float32) * scale

    def uni(shape, lo, hi):
        return jax.random.uniform(next(ks), shape, jnp.float32, lo, hi)

    return {
        "x": nrm((BATCH, SEQ, D), 1.0),
        "c": nrm((BATCH, D), 1.0),
        "ctx": nrm((BATCH, CTX_LEN, D), 1.0),
        "c_ctx": nrm((D,), 1.0),
        "ada_w": nrm((DEPTH, D, N_MOD * D), 0.5 * D ** -0.5),
        "ada_b": nrm((DEPTH, N_MOD * D), 0.02),
        "ffn_wg": nrm((DEPTH, 2, D, D_FF), D ** -0.5),
        "ffn_wu": nrm((DEPTH, 2, D, D_FF), D ** -0.5),
        "ffn_wd": nrm((DEPTH, 2, D_FF, D), D_FF ** -0.5),
        "final_g": 1.0 + nrm((D,), 0.02),
        "da_wqkv": nrm((n_a, D, 3 * D), D ** -0.5),
        "da_wo": nrm((n_a, D, D), D ** -0.5),
        "da_lam": nrm((n_a, 4, DA_HEAD_DIM), 0.1),
        "da_subln": 1.0 + nrm((n_a, 2 * DA_HEAD_DIM), 0.02),
        "gq_wqkv": nrm((n_b, D, GQ_QKV), D ** -0.5),
        "gq_wo": nrm((n_b, GQ_HEADS * GQ_HEAD_DIM, D), D ** -0.5),
        "gq_qk_g": 1.0 + nrm((n_b, 2, GQ_HEAD_DIM), 0.02),
        "rw_mu": uni((n_c, 2, 6, D), 0.0, 0.5),
        "rw_wr": nrm((n_c, D, D), D ** -0.5),
        "rw_wk": nrm((n_c, D, D), D ** -0.5),
        "rw_wv": nrm((n_c, D, D), D ** -0.5),
        "rw_wo": nrm((n_c, D, D), D ** -0.5),
        "rw_w0": uni((n_c, 2, D), -6.0, -1.0),
        "rw_w1": nrm((n_c, 2, D, RW_DECAY_LORA), D ** -0.5),
        "rw_w2": nrm((n_c, 2, RW_DECAY_LORA, D), 0.1),
        "rw_a0": nrm((n_c, 2, D), 0.1),
        "rw_a1": nrm((n_c, 2, D, RW_AAA_LORA), D ** -0.5),
        "rw_a2": nrm((n_c, 2, RW_AAA_LORA, D), 0.1),
        "rw_g1": nrm((n_c, 2, D, RW_GATE_LORA), D ** -0.5),
        "rw_g2": nrm((n_c, 2, RW_GATE_LORA, D), RW_GATE_LORA ** -0.5),
        "rw_kk": 0.85 + nrm((n_c, 2, D), 0.02),
        "rw_ka": 1.0 + nrm((n_c, 2, D), 0.02),
        "rw_rk": nrm((n_c, 2, RW_HEADS, RW_HEAD), 0.1),
        "rw_ln_g": 1.0 + nrm((n_c, 2, D), 0.02),
        "rw_ln_b": nrm((n_c, 2, D), 0.02),
    }


def reference(x, c, ctx, c_ctx, ada_w, ada_b, ffn_wg, ffn_wu, ffn_wd, final_g,
              da_wqkv, da_wo, da_lam, da_subln, gq_wqkv, gq_wo, gq_qk_g,
              rw_mu, rw_wr, rw_wk, rw_wv, rw_wo, rw_w0, rw_w1, rw_w2, rw_a0, rw_a1, rw_a2,
              rw_g1, rw_g2, rw_kk, rw_ka, rw_rk, rw_ln_g, rw_ln_b):
    h, hc = x, ctx
    c_act = jax.nn.silu(c)
    cc_act = jax.nn.silu(c_ctx)
    for i in range(DEPTH):
        kind = i % N_MIXERS
        j = i // N_MIXERS
        need_ctx = i < DEPTH - 1
        mod = jnp.split((c_act @ ada_w[i] + ada_b[i])[:, None, :], N_MOD, axis=-1)
        modc = jnp.split(cc_act @ ada_w[i] + ada_b[i], N_MOD, axis=-1)
        h = h + 0.5 * mod[2] * swiglu(modulate(h, mod[0], mod[1]), ffn_wg[i, 0], ffn_wu[i, 0], ffn_wd[i, 0])
        hc = hc + 0.5 * modc[2] * swiglu(modulate(hc, modc[0], modc[1]), ffn_wg[i, 0], ffn_wu[i, 0], ffn_wd[i, 0])
        u = modulate(h, mod[3], mod[4])
        uc = modulate(hc, modc[3], modc[4])
        if kind == 0:
            lam_init = 0.8 - 0.6 * math.exp(-0.3 * i)
            y, yc = differential_attention(u, uc, da_wqkv[j], da_wo[j], da_lam[j], da_subln[j], lam_init, need_ctx)
        elif kind == 1:
            y, yc = grouped_query_attention(u, uc, gq_wqkv[j], gq_wo[j], gq_qk_g[j], need_ctx)
        else:
            y, yc = rwkv7_bidirectional(u, uc, rw_mu[j], rw_wr[j], rw_wk[j], rw_wv[j], rw_wo[j],
                                        rw_w0[j], rw_w1[j], rw_w2[j], rw_a0[j], rw_a1[j], rw_a2[j],
                                        rw_g1[j], rw_g2[j], rw_kk[j], rw_ka[j], rw_rk[j],
                                        rw_ln_g[j], rw_ln_b[j], need_ctx)
        h = h + mod[5] * y
        h = h + 0.5 * mod[8] * swiglu(modulate(h, mod[6], mod[7]), ffn_wg[i, 1], ffn_wu[i, 1], ffn_wd[i, 1])
        if need_ctx:
            hc = hc + modc[5] * yc
            hc = hc + 0.5 * modc[8] * swiglu(modulate(hc, modc[6], modc[7]), ffn_wg[i, 1], ffn_wu[i, 1], ffn_wd[i, 1])
    return rms_norm(h, final_g)
```

```cpp
#include <hip/hip_runtime.h>
#include <hip/hip_cooperative_groups.h>
#include <cstdio>
namespace cg = cooperative_groups;

#define LAS __attribute__((address_space(3)))
#define DI __device__ __forceinline__
typedef unsigned short u16;
typedef short bf16x8 __attribute__((ext_vector_type(8)));
typedef short s16x4 __attribute__((ext_vector_type(4)));
typedef float f32x4 __attribute__((ext_vector_type(4)));
typedef float f32x2 __attribute__((ext_vector_type(2)));
typedef unsigned u32x4 __attribute__((ext_vector_type(4)));
typedef unsigned u32x2 __attribute__((ext_vector_type(2)));
typedef _Float16 h16;
typedef _Float16 h16x4 __attribute__((ext_vector_type(4)));
typedef _Float16 h16x8 __attribute__((ext_vector_type(8)));

constexpr int D = 1024, FF = 2816, NB = 8, SEQ = 4096, CTX = 256, TPB = 4352, M = NB * TPB;
constexpr int NT = 512;
constexpr size_t SLAB = (size_t)M * 1024 * 2;
constexpr size_t OFF_W1T = 0;
constexpr size_t OFF_W2T = OFF_W1T + (size_t)5632 * 1024 * 2;
constexpr size_t OFF_WMIX = OFF_W2T + (size_t)1024 * 2816 * 2;
constexpr size_t OFF_HC = OFF_WMIX + 28835840;
constexpr size_t OFF_MODS = OFF_HC + (size_t)2048 * 1024 * 4;
constexpr size_t OFF_ROPE_DA = OFF_MODS + (size_t)4 * 9 * 9216 * 4;
constexpr size_t OFF_ROPE_GQ = OFF_ROPE_DA + (size_t)4096 * 32 * 8;
constexpr size_t OFF_ARENA = OFF_ROPE_GQ + (size_t)4096 * 64 * 8;
constexpr size_t OFF_BAR = OFF_ARENA + 7 * SLAB + (SLAB / 4) * 3;
constexpr size_t WS_NEED = OFF_BAR + 256;
constexpr size_t WM_QKV = 0;
constexpr size_t WM_RW_W2 = (size_t)3840 * 3072 * 2;
constexpr size_t WM_RW_A2 = WM_RW_W2 + (size_t)2048 * 256 * 2;
constexpr size_t WM_RW_G2 = WM_RW_A2 + (size_t)2048 * 256 * 2;
constexpr size_t WM_WO = WM_RW_G2 + (size_t)2048 * 256 * 2;

#ifndef PM
#define PM 0x1FFFF
#endif
struct Params { const float* in[35]; float* out; unsigned char* ws; size_t ws_size; };
typedef const __attribute__((address_space(4))) Params* PP;
#define FRESH(q) asm volatile("" : "+s"(q))
#define TID_OPAQUE(t) int t = threadIdx.x; asm volatile("" : "+v"(t))

DI float bf2f(u16 v) { return __uint_as_float((unsigned)v << 16); }
typedef __bf16 nbf16x2 __attribute__((ext_vector_type(2)));
DI unsigned pk_bf16(float lo, float hi) { const f32x2 v = {lo, hi}; return __builtin_bit_cast(unsigned, __builtin_convertvector(v, nbf16x2)); }
DI float wave_sum(float v) {
#pragma unroll
    for (int o = 1; o < 64; o <<= 1) v += __shfl_xor(v, o);
    return v;
}
DI float sigmoidf_(float x) { return __builtin_amdgcn_rcpf(1.0f + __expf(-x)); }
DI const float* hrow_c(PP p, int r) { const int b = r / TPB, t = r % TPB; return t < CTX ? (const float*)(p->ws + OFF_HC) + ((size_t)b * CTX + t) * D : p->out + ((size_t)b * SEQ + (t - CTX)) * D; }
DI float* hrow_m(PP p, int r) { const int b = r / TPB, t = r % TPB; return t < CTX ? (float*)(p->ws + OFF_HC) + ((size_t)b * CTX + t) * D : p->out + ((size_t)b * SEQ + (t - CTX)) * D; }

namespace pg8 {
constexpr int BM = 256, BK = 64, HALF = 128, HTB = HALF * BK * 2, STAGE_BYTES = 8 * HTB, NXCD = 1, WGM = 4;
DI int lds_byte(int r, int c) { const int st = (r >> 4) * 2 + (c >> 5), rr = r & 15, cc = c & 31, ob = rr * 64 + cc * 2; return st * 1024 + (ob ^ (((ob >> 9) & 1) << 5)); }
DI void stage_rc(int b, int& R, int& C) { const int st = b / 1024, sb = b % 1024, swz = sb ^ (((sb >> 9) & 1) << 5); R = (st >> 1) * 16 + swz / 64; C = (st & 1) * 32 + (swz % 64) / 2; }
DI int perm32(int rho) { const int n = rho >> 4, i = rho & 15; return 8 * (i >> 2) + 4 * n + (i & 3); }
struct Unit { int pm, pn; };
struct Gemm { const u16* A; const u16* Bt; int M, N, K; int ash; size_t astride; };
struct StaticOrder {
    int nM, nN, nwg, G, c, lat;
    DI void init(int M_, int N_, int G_, int c_, int lat_only) { lat = lat_only; nM = lat_only ? (NB * SEQ) / BM : M_ / BM; nN = N_ / BM; nwg = nM * nN; G = G_; c = c_; }
    DI bool next(int i, Unit& u) const {
        const long L = (long)i * G + c; if (L >= nwg) return false;
        int wgid = (int)L; { const int q = nwg / NXCD, r = nwg % NXCD, xcd = wgid % NXCD, off = wgid / NXCD; wgid = (xcd < r ? xcd * (q + 1) : r * (q + 1) + (xcd - r) * q) + off; }
        const int nig = WGM * nN, gid = wgid / nig, fm = gid * WGM, gsz = (nM - fm) < WGM ? (nM - fm) : WGM;
        u.pm = fm + ((wgid % nig) % gsz); u.pn = (wgid % nig) / gsz; if (lat) u.pm += (u.pm >> 4) + 1; return true;
    }
};
template <class Epi>
DI void gemm_phase(LAS unsigned char* lds, const Gemm g, const StaticOrder& S, const Epi& E) {
    TID_OPAQUE(tid); const int wid = __builtin_amdgcn_readfirstlane(tid >> 6), lane = tid & 63, wr = wid >> 2, wc = wid & 3, fr = lane & 15, fq = lane >> 4;
    const int K = g.K, nt = K / BK;
    unsigned voffA[2], voffB[2];
#pragma unroll
    for (int i = 0; i < 2; ++i) { int R, C; stage_rc(tid * 16 + i * 8192, R, C); const int Rb = Epi::PERM ? ((R & ~31) + perm32(R & 31)) : R;
        voffA[i] = (unsigned)(R * K + C) * 2u; voffB[i] = (unsigned)(Rb * K + C) * 2u; }
    const size_t kstep = (size_t)(BK * 2);
    const size_t hstep = (size_t)HALF * K * 2;
    const size_t tstep = 2 * hstep;
    const unsigned ldsw = (unsigned)wid * 1024u;
    const int aoff = lds_byte(wr * 64 + fr, fq * 8), boff = lds_byte(wc * 32 + fr, fq * 8);
#define PG8_SA(b, h) (((b) * 2 + (h)) * HTB)
#define PG8_SB(b, h) ((4 + (b) * 2 + (h)) * HTB)
#define PG8_STAGE(bufoff, gbase, voff) do { _Pragma("unroll") for (int _i = 0; _i < 2; ++_i) \
        __builtin_amdgcn_global_load_lds((const unsigned*)((const char*)(gbase) + (voff)[_i]), (LAS unsigned*)(lds + (bufoff) + ldsw + _i * 8192), 16, 0, 0); } while (0)
#define PG8_LDA(dst, b, h) do { _Pragma("unroll") for (int m = 0; m < 4; ++m) _Pragma("unroll") for (int k = 0; k < 2; ++k) dst[m][k] = *(const LAS bf16x8*)(lds + PG8_SA(b, h) + aoff + m * 2048 + k * 1024); } while (0)
#define PG8_LDB(dst, b, h) do { _Pragma("unroll") for (int n = 0; n < 2; ++n) _Pragma("unroll") for (int k = 0; k < 2; ++k) dst[n][k] = *(const LAS bf16x8*)(lds + PG8_SB(b, h) + boff + n * 2048 + k * 1024); } while (0)
#define PG8_MMA(ai, bj, At, Bt) do { __builtin_amdgcn_s_setprio(1); _Pragma("unroll") for (int m = 0; m < 4; ++m) _Pragma("unroll") for (int n = 0; n < 2; ++n) _Pragma("unroll") for (int k = 0; k < 2; ++k) \
        acc[ai][bj][m][n] = __builtin_amdgcn_mfma_f32_16x16x32_bf16(Bt[n][k], At[m][k], acc[ai][bj][m][n], 0, 0, 0); __builtin_amdgcn_s_setprio(0); } while (0)
#define PG8_WAIT_V(n) asm volatile("s_waitcnt vmcnt(" #n ")" ::: "memory")
#define PG8_WAIT_L(n) asm volatile("s_waitcnt lgkmcnt(" #n ")" ::: "memory")
#define PG8_BAR __builtin_amdgcn_s_barrier()
#define PG8_SCHED __builtin_amdgcn_sched_barrier(0)
    Unit cur, nxt; int ui = 0;
    if (!S.next(0, cur)) return;
    f32x4 acc[2][2][4][2];
#pragma unroll
    for (int a = 0; a < 2; ++a)
#pragma unroll
        for (int b = 0; b < 2; ++b)
#pragma unroll
            for (int m = 0; m < 4; ++m)
#pragma unroll
                for (int n = 0; n < 2; ++n) acc[a][b][m][n] = (f32x4){0.f, 0.f, 0.f, 0.f};
    bf16x8 At[4][2], B0[2][2], B1[2][2];
    const char* cA = (const char*)g.A + (size_t)(cur.pn >> g.ash) * g.astride + (size_t)cur.pm * tstep; const char* cB = (const char*)g.Bt + (size_t)cur.pn * tstep;
    PG8_STAGE(PG8_SB(0, 0), cB, voffB); PG8_STAGE(PG8_SA(0, 0), cA, voffA); PG8_STAGE(PG8_SB(0, 1), cB + hstep, voffB); PG8_STAGE(PG8_SA(0, 1), cA + hstep, voffA);
    if (wr == 1) PG8_BAR;
    PG8_WAIT_V(4); PG8_BAR;
    PG8_STAGE(PG8_SB(1, 0), cB + kstep, voffB); PG8_STAGE(PG8_SA(1, 0), cA + kstep, voffA); PG8_STAGE(PG8_SB(1, 1), cB + hstep + kstep, voffB);
    PG8_WAIT_V(6); PG8_BAR;
    for (;;) {
        const bool has_next = S.next(ui + 1, nxt);
        const char* nA = has_next ? (const char*)g.A + (size_t)(nxt.pn >> g.ash) * g.astride + (size_t)nxt.pm * tstep : cA; const char* nB = has_next ? (const char*)g.Bt + (size_t)nxt.pn * tstep : cB;
        for (int t = 0; t < nt; t += 2) {
            const bool last = (t == nt - 2);
            const char* a1 = cA + (size_t)(t + 1) * kstep;
            const char* a2 = last ? nA : cA + (size_t)(t + 2) * kstep; const char* b2 = last ? nB : cB + (size_t)(t + 2) * kstep;
            const char* a3 = a2 + kstep; const char* b3 = b2 + kstep;
            PG8_LDB(B0, 0, 0); PG8_SCHED; PG8_LDA(At, 0, 0); PG8_STAGE(PG8_SA(1, 1), a1 + hstep, voffA);
            PG8_WAIT_L(8); PG8_BAR; PG8_WAIT_L(0); PG8_MMA(0, 0, At, B0); PG8_BAR; PG8_SCHED;
            PG8_LDB(B1, 0, 1); PG8_STAGE(PG8_SB(0, 0), b2, voffB);
            PG8_BAR; PG8_WAIT_L(0); PG8_MMA(0, 1, At, B1); PG8_BAR;
            PG8_LDA(At, 0, 1); PG8_STAGE(PG8_SA(0, 0), a2, voffA);
            PG8_BAR; PG8_WAIT_L(0); PG8_MMA(1, 0, At, B0); PG8_BAR; PG8_SCHED;
            PG8_STAGE(PG8_SB(0, 1), b2 + hstep, voffB);
            PG8_WAIT_V(6); PG8_BAR; PG8_MMA(1, 1, At, B1); PG8_BAR;
            PG8_LDB(B0, 1, 0); PG8_SCHED; PG8_LDA(At, 1, 0); PG8_STAGE(PG8_SA(0, 1), a2 + hstep, voffA);
            PG8_WAIT_L(8); PG8_BAR; PG8_WAIT_L(0); PG8_MMA(0, 0, At, B0); PG8_BAR; PG8_SCHED;
            PG8_LDB(B1, 1, 1); PG8_STAGE(PG8_SB(1, 0), b3, voffB);
            PG8_BAR; PG8_WAIT_L(0); PG8_MMA(0, 1, At, B1); PG8_BAR;
            PG8_LDA(At, 1, 1); PG8_STAGE(PG8_SA(1, 0), a3, voffA);
            PG8_BAR; PG8_WAIT_L(0); PG8_MMA(1, 0, At, B0); PG8_BAR; PG8_SCHED;
            PG8_STAGE(PG8_SB(1, 1), b3 + hstep, voffB);
            PG8_WAIT_V(6); PG8_BAR; PG8_MMA(1, 1, At, B1); PG8_BAR;
        }
        E(acc, cur, wr, wc, fr, fq);
        if (!has_next) break;
#pragma unroll
        for (int a = 0; a < 2; ++a)
#pragma unroll
            for (int b = 0; b < 2; ++b)
#pragma unroll
                for (int m = 0; m < 4; ++m)
#pragma unroll
                    for (int n = 0; n < 2; ++n) acc[a][b][m][n] = (f32x4){0.f, 0.f, 0.f, 0.f};
        cur = nxt; cA = nA; cB = nB; ++ui;
    }
    PG8_WAIT_V(0);
    if (wr == 0) PG8_BAR;
    PG8_BAR;
#undef PG8_SA
#undef PG8_SB
#undef PG8_STAGE
#undef PG8_LDA
#undef PG8_LDB
#undef PG8_MMA
#undef PG8_WAIT_V
#undef PG8_WAIT_L
#undef PG8_BAR
#undef PG8_SCHED
}
}
using pg8::Unit;

template <class Epi>
DI void run_gemm(LAS unsigned char* lds, const u16* A, const u16* Bt, int N, int K, const Epi& E, int lat_only = 0, int ash = 30, size_t astride = 0) {
    asm volatile("" : "+s"(K)); asm volatile("" : "+s"(N));
    pg8::StaticOrder S; S.init(M, N, (int)gridDim.x, (int)blockIdx.x, lat_only);
    pg8::Gemm g; g.A = A; g.Bt = Bt; g.M = M; g.N = N; g.K = K; g.ash = ash; g.astride = astride;
    pg8::gemm_phase<Epi>(lds, g, S, E);
    __syncthreads();
}

typedef const f32x4 (&AccRef)[2][2][4][2];
struct EpiRes {
    static constexpr bool PERM = false;
    float* out; float* hc; const float* modl; int gidx; float coef;
    DI void operator()(AccRef acc, const Unit& u, int wr, int wc, int fr, int fq) const {
        const int b = u.pm / 17, tt = u.pm % 17;
        float* hb = tt == 0 ? hc + (size_t)b * CTX * D : out + ((size_t)b * SEQ + (size_t)(tt - 1) * 256) * D;
        const float* g = modl + (size_t)(tt == 0 ? 8 : b) * 9216 + gidx * 1024;
        const int row0 = wr * 64 + fr, col0 = u.pn * 256 + wc * 32 + 4 * fq;
#pragma unroll
        for (int bj = 0; bj < 2; ++bj)
#pragma unroll
            for (int n = 0; n < 2; ++n) { const f32x4 gv = *(const f32x4*)(g + col0 + bj * 128 + n * 16) * coef;
#pragma unroll
                for (int ai = 0; ai < 2; ++ai) {
#pragma unroll
                    for (int m = 0; m < 4; ++m) { f32x4* q = (f32x4*)(hb + (size_t)(row0 + ai * 128 + m * 16) * D + col0 + bj * 128 + n * 16); *q = *q + gv * acc[ai][bj][m][n]; }
                    __builtin_amdgcn_sched_barrier(0); } }
    }
};
struct EpiFfn1 {
    static constexpr bool PERM = true;
    u16* H;
    DI void operator()(AccRef acc, const Unit& u, int wr, int wc, int fr, int fq) const {
        const int row0 = u.pm * 256 + wr * 64 + fr, hcol0 = u.pn * 128 + wc * 32 + 8 * fq;
#pragma unroll
        for (int ai = 0; ai < 2; ++ai)
#pragma unroll
            for (int m = 0; m < 4; ++m) { u16* rowp = H + (size_t)(row0 + ai * 128 + m * 16) * FF + hcol0; float v[8];
#pragma unroll
                for (int n = 0; n < 2; ++n) { const f32x4 gt = acc[ai][0][m][n], up = acc[ai][1][m][n];
#pragma unroll
                    for (int j = 0; j < 4; ++j) v[4 * n + j] = gt[j] * sigmoidf_(gt[j]) * up[j]; }
                u32x4 w; w.x = pk_bf16(v[0], v[1]); w.y = pk_bf16(v[2], v[3]); w.z = pk_bf16(v[4], v[5]); w.w = pk_bf16(v[6], v[7]); *(u32x4*)rowp = w;
                __builtin_amdgcn_sched_barrier(0); }
    }
};
template <int MODE> struct EpiStore16 {
    static constexpr bool PERM = true;
    unsigned char* ar;
    int col_base;
    DI void operator()(AccRef acc, const Unit& u, int wr, int wc, int fr, int fq) const {
        int colt = u.pn * 256 + (MODE == 2 ? col_base : 0); size_t boff; int ldc; int act = 0;
        float qs = 1.0f;
        if (MODE == 0) { const int rg = colt >> 10; boff = (size_t)((rg + 1) % 3 + 1) * SLAB; ldc = 1024; colt &= 1023; if (rg == 0) qs = 0.125f * 1.4426950408889634f; }
        else if (MODE == 1) { if (colt < 1024) { boff = 2 * SLAB; ldc = 1024; } else if (colt < 1280) { boff = 3 * SLAB; ldc = 256; colt -= 1024; } else { boff = SLAB; ldc = 256; colt -= 1280; } }
        else { if (colt < 3072) { const int rg = colt >> 10; boff = (size_t)(4 + rg) * SLAB; ldc = 1024; colt &= 1023; act = 1; }
               else { const int idx = (colt - 3072) >> 8; boff = 7 * SLAB + (size_t)idx * M * 256 * 2; ldc = 256; colt = 0; act = idx == 0 ? 2 : (idx == 1 ? 0 : 3); } }
        u16* base = (u16*)(ar + boff);
        const int row0 = u.pm * 256 + wr * 64 + fr, col0 = colt + wc * 32 + 8 * fq;
#pragma unroll
        for (int ai = 0; ai < 2; ++ai)
#pragma unroll
            for (int m = 0; m < 4; ++m) { u16* rowp = base + (size_t)(row0 + ai * 128 + m * 16) * ldc + col0;
#pragma unroll
                for (int bj = 0; bj < 2; ++bj) { f32x4 v0 = acc[ai][bj][m][0], v1 = acc[ai][bj][m][1];
                    if (MODE == 0) { v0 = v0 * qs; v1 = v1 * qs; }
                    if (act == 1) { h16x8 hv; hv[0] = (h16)v0[0]; hv[1] = (h16)v0[1]; hv[2] = (h16)v0[2]; hv[3] = (h16)v0[3]; hv[4] = (h16)v1[0]; hv[5] = (h16)v1[1]; hv[6] = (h16)v1[2]; hv[7] = (h16)v1[3];
                        *(h16x8*)(rowp + bj * 128) = hv; }
                    else {
                        if (act == 2) {
#pragma unroll
                            for (int j = 0; j < 4; ++j) { v0[j] = 1.0f - 2.0f * __builtin_amdgcn_rcpf(1.0f + __expf(2.0f * v0[j])); v1[j] = 1.0f - 2.0f * __builtin_amdgcn_rcpf(1.0f + __expf(2.0f * v1[j])); } }
                        if (act == 3) {
#pragma unroll
                            for (int j = 0; j < 4; ++j) { v0[j] = sigmoidf_(v0[j]); v1[j] = sigmoidf_(v1[j]); } }
                        u32x4 w; w.x = pk_bf16(v0[0], v0[1]); w.y = pk_bf16(v0[2], v0[3]); w.z = pk_bf16(v1[0], v1[1]); w.w = pk_bf16(v1[2], v1[3]);
                        *(u32x4*)(rowp + bj * 128) = w; } __builtin_amdgcn_sched_barrier(0); } }
    }
};
struct EpiDaQkv {
    static constexpr bool PERM = true;
    unsigned char* ar; const float* tab;
    DI void operator()(AccRef acc, const Unit& u, int wr, int wc, int fr, int fq) const {
        const int colt = u.pn * 256, rg = colt >> 10, tt = u.pm % 17;
        u16* base = (u16*)(ar + (size_t)((rg + 1) % 3 + 1) * SLAB);
        const int row0 = u.pm * 256 + wr * 64 + fr;
        if (rg == 2) {
            const int col0 = (colt & 1023) + wc * 32 + 8 * fq;
#pragma unroll
            for (int ai = 0; ai < 2; ++ai)
#pragma unroll
                for (int m = 0; m < 4; ++m) { u16* rowp = base + (size_t)(row0 + ai * 128 + m * 16) * 1024 + col0;
#pragma unroll
                    for (int bj = 0; bj < 2; ++bj) { const f32x4 v0 = acc[ai][bj][m][0], v1 = acc[ai][bj][m][1];
                        u32x4 w; w.x = pk_bf16(v0[0], v0[1]); w.y = pk_bf16(v0[2], v0[3]); w.z = pk_bf16(v1[0], v1[1]); w.w = pk_bf16(v1[2], v1[3]); *(u32x4*)(rowp + bj * 128) = w; }
                    __builtin_amdgcn_sched_barrier(0); }
            return;
        }
        const float qs = rg == 0 ? 0.125f * 1.4426950408889634f : 1.0f;
        const int col0 = (colt & 1023) + 64 * wc + 8 * fq;
#pragma unroll
        for (int ai = 0; ai < 2; ++ai)
#pragma unroll
            for (int m = 0; m < 4; ++m) { const int lr = ai * 128 + wr * 64 + m * 16 + fr; u16* rowp = base + (size_t)(row0 + ai * 128 + m * 16) * 1024 + col0;
                float x1[8], x2[8], o1[8], o2[8];
#pragma unroll
                for (int n = 0; n < 2; ++n)
#pragma unroll
                    for (int j = 0; j < 4; ++j) { x1[4 * n + j] = acc[ai][0][m][n][j] * qs; x2[4 * n + j] = acc[ai][1][m][n][j] * qs; }
                if (tt != 0) { const float* tb = tab + ((size_t)((tt - 1) * 256 + lr) * 32 + 8 * fq) * 2;
#pragma unroll
                    for (int q_ = 0; q_ < 4; ++q_) { const f32x4 cs = *(const f32x4*)(tb + 4 * q_);
                        o1[2 * q_] = x1[2 * q_] * cs[0] - x2[2 * q_] * cs[1]; o2[2 * q_] = x2[2 * q_] * cs[0] + x1[2 * q_] * cs[1];
                        o1[2 * q_ + 1] = x1[2 * q_ + 1] * cs[2] - x2[2 * q_ + 1] * cs[3]; o2[2 * q_ + 1] = x2[2 * q_ + 1] * cs[2] + x1[2 * q_ + 1] * cs[3]; } }
                else {
#pragma unroll
                    for (int j = 0; j < 8; ++j) { o1[j] = x1[j]; o2[j] = x2[j]; } }
                u32x4 w1, w2; w1.x = pk_bf16(o1[0], o1[1]); w1.y = pk_bf16(o1[2], o1[3]); w1.z = pk_bf16(o1[4], o1[5]); w1.w = pk_bf16(o1[6], o1[7]);
                w2.x = pk_bf16(o2[0], o2[1]); w2.y = pk_bf16(o2[2], o2[3]); w2.z = pk_bf16(o2[4], o2[5]); w2.w = pk_bf16(o2[6], o2[7]);
                *(u32x4*)rowp = w1; *(u32x4*)(rowp + 32) = w2;
                __builtin_amdgcn_sched_barrier(0); }
    }
};
template <int SIG> struct EpiRw2 {
    static constexpr bool PERM = true;
    h16* O; const float* bias;
    DI void operator()(AccRef acc, const Unit& u, int wr, int wc, int fr, int fq) const {
        const int row0 = u.pm * 256 + wr * 64 + fr, col0 = u.pn * 256 + wc * 32 + 8 * fq;
        f32x4 bv[2][2];
#pragma unroll
        for (int bj = 0; bj < 2; ++bj)
#pragma unroll
            for (int n = 0; n < 2; ++n) bv[bj][n] = *(const f32x4*)(bias + col0 + bj * 128 + 4 * n);
#pragma unroll
        for (int ai = 0; ai < 2; ++ai)
#pragma unroll
            for (int m = 0; m < 4; ++m) { h16* rowp = O + (size_t)(row0 + ai * 128 + m * 16) * 2048 + col0;
#pragma unroll
                for (int bj = 0; bj < 2; ++bj) { f32x4 v0 = acc[ai][bj][m][0] + bv[bj][0], v1 = acc[ai][bj][m][1] + bv[bj][1];
                    if (SIG) {
#pragma unroll
                        for (int j = 0; j < 4; ++j) { v0[j] = sigmoidf_(v0[j]); v1[j] = sigmoidf_(v1[j]); } }
                    h16x8 hv; hv[0] = (h16)v0[0]; hv[1] = (h16)v0[1]; hv[2] = (h16)v0[2]; hv[3] = (h16)v0[3]; hv[4] = (h16)v1[0]; hv[5] = (h16)v1[1]; hv[6] = (h16)v1[2]; hv[7] = (h16)v1[3];
                    *(h16x8*)(rowp + bj * 128) = hv; __builtin_amdgcn_sched_barrier(0); } }
    }
};
struct EpiRw3 {
    static constexpr bool PERM = false;
    const h16* T; u16* O;
    DI void operator()(AccRef acc, const Unit& u, int wr, int wc, int fr, int fq) const {
        const int row0 = u.pm * 256 + wr * 64 + fr, hcol0 = u.pn * 128 + wc * 16 + 4 * fq;
#pragma unroll
        for (int ai = 0; ai < 2; ++ai)
#pragma unroll
            for (int m = 0; m < 4; ++m) { const size_t row = (size_t)(row0 + ai * 128 + m * 16);
#pragma unroll
                for (int bj = 0; bj < 2; ++bj) { const int hc = hcol0 + bj * 64;
                    const h16x4 t0 = *(const h16x4*)(T + row * 2048 + hc), t1 = *(const h16x4*)(T + row * 2048 + 1024 + hc);
                    const f32x4 g0 = acc[ai][bj][m][0], g1 = acc[ai][bj][m][1]; float v[4];
#pragma unroll
                    for (int j = 0; j < 4; ++j) v[j] = (float)t0[j] * g0[j] + (float)t1[j] * g1[j];
                    u32x2 w; w.x = pk_bf16(v[0], v[1]); w.y = pk_bf16(v[2], v[3]); *(u32x2*)(O + row * 1024 + hc) = w; __builtin_amdgcn_sched_barrier(0); } }
    }
};

template <int KIND>
DI float wsrc_val(const float* s0, const float* s1, const float* s2, const float* s3, const float* s4, const float* s5, const float* mu, int ldn, int n, int k) {
    if (KIND == 0) return s0[(size_t)k * ldn + n];
    if (KIND == 1) { const int pn = n >> 8, cl = n & 255, kindg = cl >> 7, hid = 128 * pn + (cl & 127); return kindg ? s1[(size_t)k * FF + hid] : s0[(size_t)k * FF + hid]; }
    if (KIND == 2) {
        const int seg = k >> 10, kk = k & 1023; float val; int mi;
        if (n < 1024) { val = s0[(size_t)kk * 1024 + n]; mi = 0; }
        else if (n < 2048) { val = s1[(size_t)kk * 1024 + (n - 1024)]; mi = 2; }
        else if (n < 3072) { val = s2[(size_t)kk * 1024 + (n - 2048)]; mi = 3; }
        else if (n < 3328) { const int j = n - 3072; if (j >= 128) return 0.f; val = s3[((size_t)(j >> 6) * 1024 + kk) * 64 + (j & 63)]; mi = 1; }
        else if (n < 3584) { const int j = n - 3328; if (j >= 128) return 0.f; val = s4[((size_t)(j >> 6) * 1024 + kk) * 64 + (j & 63)]; mi = 4; }
        else { const int j = n - 3584; val = s5[((size_t)(j >> 7) * 1024 + kk) * 128 + (j & 127)]; mi = 5; }
        const float m0 = mu[(0 * 6 + mi) * 1024 + kk], m1 = mu[(1 * 6 + mi) * 1024 + kk];
        const float coef = seg == 0 ? 1.f - m0 - m1 : (seg == 1 ? m0 : m1);
        return coef * val;
    }
    if (KIND == 7) { int orig = n; if (n < 2048) { const int cl = n & 255; orig = (n & ~255) + 64 * ((cl >> 5) & 3) + 32 * (cl >> 7) + (cl & 31); } return s0[(size_t)k * 3072 + orig]; }
    if (KIND == 5) { if (n >= 128) return 0.f; return s0[((size_t)(n >> 6) * 1024 + k) * 64 + (n & 63)]; }
    if (KIND == 6) { return s0[((size_t)(n >> 7) * 1024 + k) * 128 + (n & 127)]; }
    if (KIND == 3) { const int d = n >> 10, col = n & 1023; if (k >= 128 || (k >> 6) != d) return 0.f; return s0[((size_t)d * 64 + (k & 63)) * 1024 + col]; }
    { const int pn = n >> 8, c = n & 255, bj = c >> 7, wc = (c & 127) >> 5, dir = (c & 31) >> 4, rest = c & 15, hcol = pn * 128 + bj * 64 + wc * 16 + rest;
      if ((k >> 7) != dir) return 0.f; return s0[((size_t)dir * 128 + (k & 127)) * 1024 + hcol]; }
}
template <int KIND>
DI void conv_tiles(LAS unsigned char* lds, const float* s0, const float* s1, const float* s2, const float* s3, const float* s4, const float* s5, const float* mu, int ldn, u16* dst, int N, int K, int& tbase) {
    LAS float* s = (LAS float*)lds;
    TID_OPAQUE(tid); const int nk = K / 64, ntile = (N / 64) * nk, gsz = gridDim.x;
    const int first = ((int)blockIdx.x - (tbase % gsz) + gsz) % gsz;
    for (int t = first; t < ntile; t += gsz) {
        const int n0 = (t / nk) * 64, k0 = (t % nk) * 64;
        __syncthreads();
#pragma unroll
        for (int i = 0; i < 8; ++i) { const int kl = (tid >> 6) + 8 * i, nl = tid & 63; s[kl * 65 + nl] = wsrc_val<KIND>(s0, s1, s2, s3, s4, s5, mu, ldn, n0 + nl, k0 + kl); }
        __syncthreads();
        const int nl = tid >> 3, kc = tid & 7;
        u32x4 o; o.x = pk_bf16(s[(kc * 8 + 0) * 65 + nl], s[(kc * 8 + 1) * 65 + nl]); o.y = pk_bf16(s[(kc * 8 + 2) * 65 + nl], s[(kc * 8 + 3) * 65 + nl]);
        o.z = pk_bf16(s[(kc * 8 + 4) * 65 + nl], s[(kc * 8 + 5) * 65 + nl]); o.w = pk_bf16(s[(kc * 8 + 6) * 65 + nl], s[(kc * 8 + 7) * 65 + nl]);
        *(u32x4*)(dst + (size_t)(n0 + nl) * K + k0 + kc * 8) = o;
    }
    tbase += ntile;
}
DI void conv_ffn(LAS unsigned char* lds, PP p, int layer, int which, int& tb) {
    FRESH(p);
    const float* z = nullptr;
    conv_tiles<1>(lds, p->in[6] + ((size_t)layer * 2 + which) * D * FF, p->in[7] + ((size_t)layer * 2 + which) * D * FF, z, z, z, z, z, 0, (u16*)(p->ws + OFF_W1T), 5632, 1024, tb);
    conv_tiles<0>(lds, p->in[8] + ((size_t)layer * 2 + which) * FF * D, z, z, z, z, z, z, 1024, (u16*)(p->ws + OFF_W2T), 1024, 2816, tb);
}
DI void conv_mixer(LAS unsigned char* lds, PP p, int layer, int& tb) {
    FRESH(p);
    const int kind = layer % 3, j = layer / 3; const float* z = nullptr;
    unsigned char* wm = p->ws + OFF_WMIX;
    if (kind == 0) {
        conv_tiles<7>(lds, p->in[10] + (size_t)j * D * 3072, z, z, z, z, z, z, 3072, (u16*)(wm + WM_QKV), 3072, 1024, tb);
        conv_tiles<0>(lds, p->in[11] + (size_t)j * D * D, z, z, z, z, z, z, 1024, (u16*)(wm + WM_WO), 1024, 1024, tb);
    } else if (kind == 1) {
        conv_tiles<0>(lds, p->in[14], z, z, z, z, z, z, 1536, (u16*)(wm + WM_QKV), 1536, 1024, tb);
        conv_tiles<0>(lds, p->in[15], z, z, z, z, z, z, 1024, (u16*)(wm + WM_WO), 1024, 1024, tb);
    } else {
        conv_tiles<0>(lds, p->in[18], z, z, z, z, z, z, 1024, (u16*)(wm + WM_QKV), 1024, 1024, tb);
        conv_tiles<0>(lds, p->in[19], z, z, z, z, z, z, 1024, (u16*)(wm + WM_QKV) + (size_t)1024 * 1024, 1024, 1024, tb);
        conv_tiles<0>(lds, p->in[20], z, z, z, z, z, z, 1024, (u16*)(wm + WM_QKV) + (size_t)2048 * 1024, 1024, 1024, tb);
        conv_tiles<5>(lds, p->in[23], z, z, z, z, z, z, 0, (u16*)(wm + WM_QKV) + (size_t)3072 * 1024, 256, 1024, tb);
        conv_tiles<5>(lds, p->in[26], z, z, z, z, z, z, 0, (u16*)(wm + WM_QKV) + (size_t)3328 * 1024, 256, 1024, tb);
        conv_tiles<6>(lds, p->in[28], z, z, z, z, z, z, 0, (u16*)(wm + WM_QKV) + (size_t)3584 * 1024, 256, 1024, tb);
        conv_tiles<3>(lds, p->in[24], z, z, z, z, z, z, 0, (u16*)(wm + WM_RW_W2), 2048, 256, tb);
        conv_tiles<3>(lds, p->in[27], z, z, z, z, z, z, 0, (u16*)(wm + WM_RW_A2), 2048, 256, tb);
        conv_tiles<4>(lds, p->in[29], z, z, z, z, z, z, 0, (u16*)(wm + WM_RW_G2), 2048, 256, tb);
        conv_tiles<0>(lds, p->in[21], z, z, z, z, z, z, 1024, (u16*)(wm + WM_WO), 1024, 1024, tb);
    }
}

DI void phase_modulate(PP p, int layer, int shi, int sci, u16* XN) {
    FRESH(p); TID_OPAQUE(tid_); const int lane = tid_ & 63, gw = blockIdx.x * 8 + (tid_ >> 6), NW = gridDim.x * 8;
    const float* mods = (const float*)(p->ws + OFF_MODS) + (size_t)layer * 9 * 9216;
    for (int r = gw; r < M; r += NW) {
        const float* hr = hrow_c(p, r); const int b = r / TPB, t = r % TPB;
        const float* md = mods + (size_t)(t < CTX ? 8 : b) * 9216;
        f32x4 v[4]; float s = 0.f;
#pragma unroll
        for (int j = 0; j < 4; ++j) { v[j] = *(const f32x4*)(hr + 4 * lane + 256 * j); s += v[j][0] * v[j][0] + v[j][1] * v[j][1] + v[j][2] * v[j][2] + v[j][3] * v[j][3]; }
        s = wave_sum(s); const float rstd = 1.0f / sqrtf(s * (1.0f / 1024.0f) + 1e-6f);
#pragma unroll
        for (int j = 0; j < 4; ++j) { const int col = 4 * lane + 256 * j; const f32x4 sc = *(const f32x4*)(md + sci * 1024 + col), sh = *(const f32x4*)(md + shi * 1024 + col);
            const f32x4 o = v[j] * rstd * (sc + 1.0f) + sh; u32x2 w; w.x = pk_bf16(o[0], o[1]); w.y = pk_bf16(o[2], o[3]); *(u32x2*)(XN + (size_t)r * 1024 + col) = w; }
    }
}
DI f32x4 bf4_to_f32(u32x2 v) { f32x4 o; o[0] = __uint_as_float(v.x << 16); o[1] = __uint_as_float(v.x & 0xffff0000u); o[2] = __uint_as_float(v.y << 16); o[3] = __uint_as_float(v.y & 0xffff0000u); return o; }
DI void phase_mix(PP p, const u16* U, u16* O0, u16* O1, u16* O2, int i0, int i1, int i2) {
    FRESH(p); TID_OPAQUE(tid_); const int lane = tid_ & 63, gw = blockIdx.x * 8 + (tid_ >> 6), NW = gridDim.x * 8;
    const float* mu = p->in[17];
    const int rpw = (M + NW - 1) / NW;
    const int r0 = gw * rpw, r1 = (r0 + rpw < M) ? r0 + rpw : M;
    if (r0 >= M) return;
#pragma unroll 1
    for (int j = 0; j < 4; ++j) { const int col = 4 * lane + 256 * j;
        const f32x4 p0 = *(const f32x4*)(mu + (size_t)i0 * 1024 + col), n0 = *(const f32x4*)(mu + (size_t)(6 + i0) * 1024 + col);
        const f32x4 p1 = *(const f32x4*)(mu + (size_t)i1 * 1024 + col), n1 = *(const f32x4*)(mu + (size_t)(6 + i1) * 1024 + col);
        const f32x4 p2 = *(const f32x4*)(mu + (size_t)i2 * 1024 + col), n2 = *(const f32x4*)(mu + (size_t)(6 + i2) * 1024 + col);
        f32x4 cur = bf4_to_f32(*(const u32x2*)(U + (size_t)r0 * 1024 + col));
        f32x4 prev = (r0 > 0) ? bf4_to_f32(*(const u32x2*)(U + (size_t)(r0 - 1) * 1024 + col)) : (f32x4){0.f, 0.f, 0.f, 0.f};
#pragma unroll 1
        for (int r = r0; r < r1; ++r) {
            const int t = r % TPB; const bool first = (t == 0) || (t == CTX), last = (t == CTX - 1) || (t == TPB - 1);
            const f32x4 nx = (r + 1 < M) ? bf4_to_f32(*(const u32x2*)(U + (size_t)(r + 1) * 1024 + col)) : (f32x4){0.f, 0.f, 0.f, 0.f};
            const f32x4 z4 = {0.f, 0.f, 0.f, 0.f};
            const f32x4 dp = (first ? z4 : prev) - cur, dn = (last ? z4 : nx) - cur;
            { const f32x4 o = cur + dp * p0 + dn * n0; u32x2 w; w.x = pk_bf16(o[0], o[1]); w.y = pk_bf16(o[2], o[3]); *(u32x2*)(O0 + (size_t)r * 1024 + col) = w; }
            { const f32x4 o = cur + dp * p1 + dn * n1; u32x2 w; w.x = pk_bf16(o[0], o[1]); w.y = pk_bf16(o[2], o[3]); *(u32x2*)(O1 + (size_t)r * 1024 + col) = w; }
            { const f32x4 o = cur + dp * p2 + dn * n2; u32x2 w; w.x = pk_bf16(o[0], o[1]); w.y = pk_bf16(o[2], o[3]); *(u32x2*)(O2 + (size_t)r * 1024 + col) = w; }
            prev = cur; cur = nx;
        }
    }
}
DI void transpose_v(LAS unsigned char* lds, const u16* V, int vcols, u16* VT) {
    LAS u16* s = (LAS u16*)lds;
    TID_OPAQUE(tid); const int nct = vcols / 64, ntile = (M / 64) * nct;
    for (int t = blockIdx.x; t < ntile; t += gridDim.x) {
        const int r0 = (t / nct) * 64, c0 = (t % nct) * 64, b = r0 / TPB, t0 = r0 % TPB;
        __syncthreads();
        { const int tr = tid >> 3, cc = tid & 7; *(LAS u32x4*)(s + tr * 72 + cc * 8) = *(const u32x4*)(V + (size_t)(r0 + tr) * vcols + c0 + cc * 8); }
        __syncthreads();
        { const int col = tid >> 3, tc = tid & 7; u16 e[8];
#pragma unroll
          for (int j = 0; j < 8; ++j) e[j] = s[(tc * 8 + j) * 72 + col];
          u32x4 o; o.x = e[0] | ((unsigned)e[1] << 16); o.y = e[2] | ((unsigned)e[3] << 16); o.z = e[4] | ((unsigned)e[5] << 16); o.w = e[6] | ((unsigned)e[7] << 16);
          *(u32x4*)(VT + ((size_t)b * vcols + c0 + col) * TPB + t0 + tc * 8) = o; }
    }
}
DI void rope_da(PP p, u16* Q, u16* K) {
    FRESH(p); TID_OPAQUE(tid_); const int lane = tid_ & 63, gw = blockIdx.x * 8 + (tid_ >> 6), NW = gridDim.x * 8;
    const float* tab = (const float*)(p->ws + OFF_ROPE_DA);
    const int N = 2 * NB * SEQ;
    for (int i = gw; i < N; i += 2 * NW) {
        u16* base[2]; const float* tb[2]; u32x4 a[2], c[2]; f32x4 cs[2][4]; bool ok[2];
#pragma unroll
        for (int u = 0; u < 2; ++u) { const int ii = i + u * NW; ok[u] = ii < N; const int iv = ok[u] ? ii : i;
            const int which = iv & 1, lr = iv >> 1, b = lr / SEQ, sp = lr % SEQ; const size_t r = (size_t)b * TPB + CTX + sp;
            base[u] = (which ? K : Q) + r * 1024 + (lane >> 2) * 64 + (lane & 3) * 8; tb[u] = tab + ((size_t)sp * 32 + (lane & 3) * 8) * 2;
            a[u] = *(const u32x4*)base[u]; c[u] = *(const u32x4*)(base[u] + 32);
#pragma unroll
            for (int j = 0; j < 4; ++j) cs[u][j] = *(const f32x4*)(tb[u] + 4 * j); }
#pragma unroll
        for (int u = 0; u < 2; ++u) { if (!ok[u]) continue; u32x4 oa, oc;
#pragma unroll
            for (int j = 0; j < 4; ++j) {
                const float x1a = __uint_as_float(a[u][j] << 16), x1b = __uint_as_float(a[u][j] & 0xffff0000u), x2a = __uint_as_float(c[u][j] << 16), x2b = __uint_as_float(c[u][j] & 0xffff0000u);
                oa[j] = pk_bf16(x1a * cs[u][j][0] - x2a * cs[u][j][1], x1b * cs[u][j][2] - x2b * cs[u][j][3]); oc[j] = pk_bf16(x2a * cs[u][j][0] + x1a * cs[u][j][1], x2b * cs[u][j][2] + x1b * cs[u][j][3]); }
            *(u32x4*)base[u] = oa; *(u32x4*)(base[u] + 32) = oc; }
    }
}
DI void qknorm_rope_gq(PP p, u16* Q, u16* K) {
    FRESH(p); TID_OPAQUE(tid_); const int lane = tid_ & 63, gw = blockIdx.x * 8 + (tid_ >> 6), NW = gridDim.x * 8;
    const float* tab = (const float*)(p->ws + OFF_ROPE_GQ); const float* gq = p->in[16];
    for (int r = gw; r < M; r += NW) {
        const int t = r % TPB; const bool lat = t >= CTX; const int sp = lat ? t - CTX : 0;
        const int hd = lane >> 3, j0 = (lane & 7) * 8;
#pragma unroll
        for (int which = 0; which < 2; ++which) {
            if (which == 1 && hd >= 2) continue;
            const float qsc = which == 0 ? 0.08838834764831845f * 1.4426950408889634f : 1.0f;
            u16* base = (which ? K + (size_t)r * 256 : Q + (size_t)r * 1024) + hd * 128 + j0; const float* g = gq + which * 128;
            const u32x4 a = *(const u32x4*)base, c = *(const u32x4*)(base + 64);
            float x1[8], x2[8]; float ss = 0.f;
#pragma unroll
            for (int j = 0; j < 4; ++j) { x1[2 * j] = __uint_as_float(a[j] << 16); x1[2 * j + 1] = __uint_as_float(a[j] & 0xffff0000u); x2[2 * j] = __uint_as_float(c[j] << 16); x2[2 * j + 1] = __uint_as_float(c[j] & 0xffff0000u); }
#pragma unroll
            for (int j = 0; j < 8; ++j) ss += x1[j] * x1[j] + x2[j] * x2[j];
            ss += __shfl_xor(ss, 1); ss += __shfl_xor(ss, 2); ss += __shfl_xor(ss, 4);
            const float rstd = 1.0f / sqrtf(ss * (1.0f / 128.0f) + 1e-6f);
            float o1[8], o2[8];
#pragma unroll
            for (int j = 0; j < 8; ++j) { const float y1 = x1[j] * rstd * g[j0 + j], y2 = x2[j] * rstd * g[64 + j0 + j];
                float cs = 1.f, sn = 0.f; if (lat) { cs = tab[((size_t)sp * 64 + j0 + j) * 2]; sn = tab[((size_t)sp * 64 + j0 + j) * 2 + 1]; }
                o1[j] = (y1 * cs - y2 * sn) * qsc; o2[j] = (y2 * cs + y1 * sn) * qsc; }
            u32x4 oa, oc;
#pragma unroll
            for (int j = 0; j < 4; ++j) { oa[j] = pk_bf16(o1[2 * j], o1[2 * j + 1]); oc[j] = pk_bf16(o2[2 * j], o2[2 * j + 1]); }
            *(u32x4*)base = oa; *(u32x4*)(base + 64) = oc;
        }
    }
}
DI void combine_da(PP p, int j, int layer, const u16* O, u16* OUT) {
    asm volatile("" : "+s"(layer));
    const float lam_init = layer == 0 ? 0.2f : 0.55605820416f;
    FRESH(p); TID_OPAQUE(tid_); const int lane = tid_ & 63, gw = blockIdx.x * 8 + (tid_ >> 6), NW = gridDim.x * 8;
    const float* lv = p->in[12] + (size_t)j * 256; const float* sg = p->in[13] + (size_t)j * 128;
    const float lam = expf(wave_sum(lv[lane] * lv[64 + lane])) - expf(wave_sum(lv[128 + lane] * lv[192 + lane])) + lam_init;
    const int hd = lane >> 3, d0 = (lane & 7) * 16;
    for (int r = gw; r < M; r += NW) {
        const u16* o0 = O + (size_t)r * 2048 + (2 * hd) * 128 + d0; const u16* o1 = o0 + 128;
        float v[16]; float ss = 0.f;
#pragma unroll
        for (int q = 0; q < 2; ++q) { const u32x4 a = *(const u32x4*)(o0 + 8 * q), c = *(const u32x4*)(o1 + 8 * q);
#pragma unroll
            for (int jj = 0; jj < 4; ++jj) { v[8 * q + 2 * jj] = __uint_as_float(a[jj] << 16) - lam * __uint_as_float(c[jj] << 16); v[8 * q + 2 * jj + 1] = __uint_as_float(a[jj] & 0xffff0000u) - lam * __uint_as_float(c[jj] & 0xffff0000u); } }
#pragma unroll
        for (int q = 0; q < 16; ++q) ss += v[q] * v[q];
        ss += __shfl_xor(ss, 1); ss += __shfl_xor(ss, 2); ss += __shfl_xor(ss, 4);
        const float sc = (1.0f - lam_init) / sqrtf(ss * (1.0f / 128.0f) + 1e-6f);
        u32x4 w0, w1;
#pragma unroll
        for (int jj = 0; jj < 4; ++jj) { w0[jj] = pk_bf16(v[2 * jj] * sc * sg[d0 + 2 * jj], v[2 * jj + 1] * sc * sg[d0 + 2 * jj + 1]); w1[jj] = pk_bf16(v[8 + 2 * jj] * sc * sg[d0 + 8 + 2 * jj], v[8 + 2 * jj + 1] * sc * sg[d0 + 8 + 2 * jj + 1]); }
        u16* dst = OUT + (size_t)r * 1024 + hd * 128 + d0; *(u32x4*)dst = w0; *(u32x4*)(dst + 8) = w1;
    }
}
DI void phase_final(PP p) {
    FRESH(p); TID_OPAQUE(tid_); const int lane = tid_ & 63, gw = blockIdx.x * 8 + (tid_ >> 6), NW = gridDim.x * 8; const float* fg = p->in[9];
    for (int r = gw; r < NB * SEQ; r += NW) {
        float* hr = p->out + (size_t)r * D; f32x4 v[4]; float s = 0.f;
#pragma unroll
        for (int j = 0; j < 4; ++j) { v[j] = *(const f32x4*)(hr + 4 * lane + 256 * j); s += v[j][0] * v[j][0] + v[j][1] * v[j][1] + v[j][2] * v[j][2] + v[j][3] * v[j][3]; }
        s = wave_sum(s); const float rstd = 1.0f / sqrtf(s * (1.0f / 1024.0f) + 1e-6f);
#pragma unroll
        for (int j = 0; j < 4; ++j) { const int col = 4 * lane + 256 * j; f32x4 o = v[j] * rstd * *(const f32x4*)(fg + col);
#ifdef SCRUB
            for (int q = 0; q < 4; ++q) if (!(fabsf(o[q]) < 1e30f)) o[q] = 1000.0f;
#endif
            *(f32x4*)(hr + col) = o; }
    }
}

template <int KS, bool DA>
DI void attn_phase(LAS unsigned char* lds, const u16* Q, const u16* K, int ldk, const u16* VT, int vtr, u16* O, int ldo, int NH, bool need_ctx) {
    constexpr int DQK = KS * 32, KSTR = DQK * 2 + 16, VSTR = 144, KBUF = 64 * KSTR, VBUF = 128 * VSTR;
    constexpr int KCH = DQK / 8;
    constexpr int KIT = (64 * KCH) / NT;
    TID_OPAQUE(tid); const int wave = __builtin_amdgcn_readfirstlane(tid >> 6), lane = tid & 63, fr = lane & 15, g = lane >> 4;
    const bool late = false;
    const int n_lat = NB * NH * 16, total = need_ctx ? n_lat + NB * NH : n_lat;
    LAS unsigned char* kb0 = lds; LAS unsigned char* vb0 = lds + 2 * KBUF;
#define AT_QK(kb_) do { constexpr int KPB = 4 / KS;     \
        bf16x8 fa_[4], fb_[4]; \
        _Pragma("unroll") for (int q_ = 0; q_ < 4; ++q_) fa_[q_] = *(const LAS bf16x8*)((kb_) + ((q_ / KS) * 16 + fr) * KSTR + (q_ % KS) * 64 + g * 16); \
        _Pragma("unroll") for (int kt = 0; kt < 4; kt += 2 * KPB) { \
            _Pragma("unroll") for (int q_ = 0; q_ < 4; ++q_) fb_[q_] = *(const LAS bf16x8*)((kb_) + ((kt + KPB + q_ / KS) * 16 + fr) * KSTR + (q_ % KS) * 64 + g * 16); \
            __builtin_amdgcn_sched_barrier(0); \
            _Pragma("unroll") for (int k_ = 0; k_ < KPB; ++k_) { s[kt + k_][0] = (f32x4){-mrun[0], -mrun[0], -mrun[0], -mrun[0]}; s[kt + k_][1] = (f32x4){-mrun[1], -mrun[1], -mrun[1], -mrun[1]}; \
                _Pragma("unroll") for (int ks = 0; ks < KS; ++ks) { s[kt + k_][0] = __builtin_amdgcn_mfma_f32_16x16x32_bf16(fa_[k_ * KS + ks], qf[0][ks], s[kt + k_][0], 0, 0, 0); \
                    s[kt + k_][1] = __builtin_amdgcn_mfma_f32_16x16x32_bf16(fa_[k_ * KS + ks], qf[1][ks], s[kt + k_][1], 0, 0, 0); } } \
            __builtin_amdgcn_sched_barrier(0); \
            if (kt + 2 * KPB < 4) { _Pragma("unroll") for (int q_ = 0; q_ < 4; ++q_) fa_[q_] = *(const LAS bf16x8*)((kb_) + ((kt + 2 * KPB + q_ / KS) * 16 + fr) * KSTR + (q_ % KS) * 64 + g * 16); } \
            __builtin_amdgcn_sched_barrier(0); \
            _Pragma("unroll") for (int k_ = 0; k_ < KPB; ++k_) { s[kt + KPB + k_][0] = (f32x4){-mrun[0], -mrun[0], -mrun[0], -mrun[0]}; s[kt + KPB + k_][1] = (f32x4){-mrun[1], -mrun[1], -mrun[1], -mrun[1]}; \
                _Pragma("unroll") for (int ks = 0; ks < KS; ++ks) { s[kt + KPB + k_][0] = __builtin_amdgcn_mfma_f32_16x16x32_bf16(fb_[k_ * KS + ks], qf[0][ks], s[kt + KPB + k_][0], 0, 0, 0); \
                    s[kt + KPB + k_][1] = __builtin_amdgcn_mfma_f32_16x16x32_bf16(fb_[k_ * KS + ks], qf[1][ks], s[kt + KPB + k_][1], 0, 0, 0); } } \
            __builtin_amdgcn_sched_barrier(0); } } while (0)
#define AT_SM(force_) do { _Pragma("unroll") for (int qt = 0; qt < 2; ++qt) {   \
        float mx = s[0][qt][0]; \
        _Pragma("unroll") for (int kt = 0; kt < 4; ++kt) _Pragma("unroll") for (int j = 0; j < 4; ++j) mx = fmaxf(mx, s[kt][qt][j]); \
        if ((force_) || __any(mx > 8.0f)) {   \
            mx = fmaxf(mx, __shfl_xor(mx, 16)); mx = fmaxf(mx, __shfl_xor(mx, 32)); \
            const float dm = (force_) ? mx : fmaxf(mx, 0.f), alpha = (force_) ? 1.0f : __builtin_amdgcn_exp2f(-dm);     \
            mrun[qt] += dm; lsum[qt] *= alpha; \
            _Pragma("unroll") for (int dt = 0; dt < 8; ++dt) oacc[dt][qt] = oacc[dt][qt] * alpha; \
            _Pragma("unroll") for (int kt = 0; kt < 4; ++kt) s[kt][qt] = s[kt][qt] - dm; } \
        float ps = 0.f; float pv[4][4]; \
        _Pragma("unroll") for (int kt = 0; kt < 4; ++kt) _Pragma("unroll") for (int j = 0; j < 4; ++j) { pv[kt][j] = __builtin_amdgcn_exp2f(s[kt][qt][j]); ps += pv[kt][j]; } \
        lsum[qt] += ps; \
        _Pragma("unroll") for (int k2 = 0; k2 < 2; ++k2) { u32x4 w_; w_.x = pk_bf16(pv[2 * k2][0], pv[2 * k2][1]); w_.y = pk_bf16(pv[2 * k2][2], pv[2 * k2][3]); \
            w_.z = pk_bf16(pv[2 * k2 + 1][0], pv[2 * k2 + 1][1]); w_.w = pk_bf16(pv[2 * k2 + 1][2], pv[2 * k2 + 1][3]); pb[k2][qt] = __builtin_bit_cast(bf16x8, w_); } } } while (0)
#define AT_PV_PRE(vb_) do { _Pragma("unroll") for (int q_ = 0; q_ < 4; ++q_) va_[q_] = *(const LAS bf16x8*)((vb_) + ((q_ >> 1) * 16 + fr) * VSTR + (q_ & 1) * 64 + g * 16); } while (0)
#define AT_PV(vb_) do { bf16x8 vb2_[4];     \
        _Pragma("unroll") for (int dt = 0; dt < 8; dt += 4) { \
            _Pragma("unroll") for (int q_ = 0; q_ < 4; ++q_) vb2_[q_] = *(const LAS bf16x8*)((vb_) + ((dt + 2 + (q_ >> 1)) * 16 + fr) * VSTR + (q_ & 1) * 64 + g * 16); \
            __builtin_amdgcn_sched_barrier(0); \
            _Pragma("unroll") for (int q_ = 0; q_ < 4; ++q_) { oacc[dt + (q_ >> 1)][0] = __builtin_amdgcn_mfma_f32_16x16x32_bf16(va_[q_], pb[q_ & 1][0], oacc[dt + (q_ >> 1)][0], 0, 0, 0); \
                oacc[dt + (q_ >> 1)][1] = __builtin_amdgcn_mfma_f32_16x16x32_bf16(va_[q_], pb[q_ & 1][1], oacc[dt + (q_ >> 1)][1], 0, 0, 0); } \
            __builtin_amdgcn_sched_barrier(0); \
            if (dt + 4 < 8) { _Pragma("unroll") for (int q_ = 0; q_ < 4; ++q_) va_[q_] = *(const LAS bf16x8*)((vb_) + ((dt + 4 + (q_ >> 1)) * 16 + fr) * VSTR + (q_ & 1) * 64 + g * 16); } \
            __builtin_amdgcn_sched_barrier(0); \
            _Pragma("unroll") for (int q_ = 0; q_ < 4; ++q_) { oacc[dt + 2 + (q_ >> 1)][0] = __builtin_amdgcn_mfma_f32_16x16x32_bf16(vb2_[q_], pb[q_ & 1][0], oacc[dt + 2 + (q_ >> 1)][0], 0, 0, 0); \
                oacc[dt + 2 + (q_ >> 1)][1] = __builtin_amdgcn_mfma_f32_16x16x32_bf16(vb2_[q_], pb[q_ & 1][1], oacc[dt + 2 + (q_ >> 1)][1], 0, 0, 0); } \
            __builtin_amdgcn_sched_barrier(0); } } while (0)
#define AT_WRITE(kdst_, vdst_) do { _Pragma("unroll") for (int i = 0; i < KIT; ++i) { const int c = tid + NT * i; *(LAS u32x4*)((kdst_) + (c / KCH) * KSTR + (c % KCH) * 16) = kreg[i]; } \
        _Pragma("unroll") for (int i = 0; i < 2; ++i) { const int c = tid + NT * i, kc = c & 7, kk = kc & 3; const int d_ = c >> 3, rho_ = (((d_ >> 5) * 2 + ((d_ >> 2) & 1)) << 4) + (((d_ >> 3) & 3) << 2) + (d_ & 3);     \
            LAS unsigned char* vp = (vdst_) + rho_ * VSTR + (kc >> 2) * 64 + 32 * (kk & 1) + 8 * (kk >> 1); \
            *(LAS u32x2*)vp = (u32x2){vreg[i].x, vreg[i].y}; *(LAS u32x2*)(vp + 16) = (u32x2){vreg[i].z, vreg[i].w}; } } while (0)
    for (int it0 = blockIdx.x; it0 < total; it0 += gridDim.x) {
        int it = it0;
        if (gridDim.x == 256 && it0 < n_lat) { const int rnd = it0 >> 8, bi = it0 & 255, x = bi & 7, slot = bi >> 3; it = (rnd << 8) + ((((x << 1) + (slot >> 4))) << 4) + (slot & 15); }
        int b, hh, qoff, nk;
        if (it < n_lat) { const int qb = it & 15; hh = (it >> 4) % NH; b = (it >> 4) / NH; qoff = CTX + qb * 256; nk = TPB; }
        else { const int c = it - n_lat; hh = c % NH; b = c / NH; qoff = 0; nk = CTX; }
        const int ntile = nk / 64;
        const size_t qrow0 = (size_t)b * TPB + qoff + wave * 32;
        const int kcol0 = DA ? hh * 64 : (hh >> 2) * 128, vrow0 = DA ? (hh >> 1) * 128 : (hh >> 2) * 128;
        const u16* Kb = K + (size_t)b * TPB * ldk + kcol0; const u16* Vb = VT + ((size_t)b * vtr + vrow0) * TPB;
        bf16x8 qf[2][KS];
#pragma unroll
        for (int qt = 0; qt < 2; ++qt)
#pragma unroll
            for (int ks = 0; ks < KS; ++ks) qf[qt][ks] = *(const bf16x8*)(Q + (qrow0 + qt * 16 + fr) * 1024 + hh * DQK + ks * 32 + g * 8);
        f32x4 oacc[8][2];
#pragma unroll
        for (int dt = 0; dt < 8; ++dt) { oacc[dt][0] = (f32x4){0.f, 0.f, 0.f, 0.f}; oacc[dt][1] = (f32x4){0.f, 0.f, 0.f, 0.f}; }
        float mrun[2] = {0.f, 0.f}, lsum[2] = {0.f, 0.f};
        u32x4 kreg[KIT], vreg[2];
        f32x4 s[4][2]; bf16x8 pb[2][2];
#pragma unroll
        for (int i = 0; i < KIT; ++i) { const int c = tid + NT * i; kreg[i] = *(const u32x4*)(Kb + (size_t)(c / KCH) * ldk + (c % KCH) * 8); }
#pragma unroll
        for (int i = 0; i < 2; ++i) { const int c = tid + NT * i; vreg[i] = *(const u32x4*)(Vb + (size_t)(c >> 3) * TPB + (c & 7) * 8); }
        __syncthreads();
        AT_WRITE(kb0, vb0);
        __syncthreads();
        int vcur = 0, vprev = 2;
        for (int t = 0; t < ntile; ++t) {
            LAS unsigned char* kb = kb0 + (t & 1) * KBUF;
            const bool more = (t + 1 < ntile);
            if (more) {
                const u16* Kt = Kb + (size_t)(t + 1) * 64 * ldk; const u16* Vt = Vb + (t + 1) * 64;
#pragma unroll
                for (int i = 0; i < KIT; ++i) { const int c = tid + NT * i; kreg[i] = *(const u32x4*)(Kt + (size_t)(c / KCH) * ldk + (c % KCH) * 8); }
#pragma unroll
                for (int i = 0; i < 2; ++i) { const int c = tid + NT * i; vreg[i] = *(const u32x4*)(Vt + (size_t)(c >> 3) * TPB + (c & 7) * 8); }
            }
            AT_QK(kb);
            bf16x8 va_[4]; AT_PV_PRE(vb0 + vcur * VBUF);
            AT_SM(t == 0);
            const int vnext = (vcur == 2) ? 0 : vcur + 1;
            if (more) AT_WRITE(kb0 + ((t + 1) & 1) * KBUF, vb0 + vnext * VBUF);
            AT_PV(vb0 + vcur * VBUF);
            __syncthreads();
            vprev = vcur; vcur = vnext;
        }
#pragma unroll
        for (int qt = 0; qt < 2; ++qt) {
            float l = lsum[qt]; l += __shfl_xor(l, 16); l += __shfl_xor(l, 32); const float inv = 1.0f / l;
            u16* orow = O + (qrow0 + qt * 16 + fr) * ldo + hh * 128 + 8 * g;
#pragma unroll
            for (int m2 = 0; m2 < 4; ++m2) { const f32x4 o0 = oacc[2 * m2][qt] * inv, o1 = oacc[2 * m2 + 1][qt] * inv;
                u32x4 w; w.x = pk_bf16(o0[0], o0[1]); w.y = pk_bf16(o0[2], o0[3]); w.z = pk_bf16(o1[0], o1[1]); w.w = pk_bf16(o1[2], o1[3]); *(u32x4*)(orow + m2 * 32) = w; }
        }
    }
    __syncthreads();
#undef AT_QK
#undef AT_SM
#undef AT_PV
#undef AT_PV_PRE
#undef AT_WRITE
}

DI float dpp_red8(float x) {
    x += __builtin_bit_cast(float, __builtin_amdgcn_update_dpp(0, __builtin_bit_cast(int, x), 0xB1, 0xF, 0xF, true));
    x += __builtin_bit_cast(float, __builtin_amdgcn_update_dpp(0, __builtin_bit_cast(int, x), 0x4E, 0xF, 0xF, true));
    x += __builtin_bit_cast(float, __builtin_amdgcn_update_dpp(0, __builtin_bit_cast(int, x), 0x141, 0xF, 0xF, true));
    return x;
}
DI float dpp_red16(float x) {
    x = dpp_red8(x);
    x += __builtin_bit_cast(float, __builtin_amdgcn_update_dpp(0, __builtin_bit_cast(int, x), 0x140, 0xF, 0xF, true));
    return x;
}
constexpr int SCT = 32;
DI void phase_scan(LAS unsigned char* lds, PP p, const h16* R, const h16* Kx, const h16* V, h16* WP  , const h16* AA, bool do_store) {
    LAS float* LW = (LAS float*)lds; LAS float* LA = LW + SCT * 64; LAS float* LB = LA + SCT * 64; LAS float* LK = LB + SCT * 64; LAS float* LR = LK + SCT * 64; LAS float* LV = LR + SCT * 64; LAS float* LY = LV + SCT * 64;
    FRESH(p); TID_OPAQUE(tid); const int wave = tid >> 6, lane = tid & 63, row = tid >> 3, ks = tid & 7;
    for (int item0 = blockIdx.x; item0 < NB * 16 * 2; item0 += gridDim.x) {
        const int item = (gridDim.x == 256) ? ((item0 & 7) << 5) + (item0 >> 3) : item0;
        const int dir = item & 1, h = (item >> 1) & 15, b = item >> 5;
        const float kkc = p->in[30][dir * 1024 + h * 64 + lane], kac = p->in[31][dir * 1024 + h * 64 + lane];
        const size_t cshared = (size_t)h * 64 + lane, cdir = (size_t)dir * 1024 + h * 64 + lane;
        const int roc = dir * 1024 + h * 64 + (tid & 15) * 4;
        const f32x4 ro_rk = *(const f32x4*)(p->in[32] + roc), ro_g = *(const f32x4*)(p->in[33] + roc), ro_b = *(const f32x4*)(p->in[34] + roc);
        f32x2 S[4];
#pragma unroll
        for (int j = 0; j < 4; ++j) S[j] = (f32x2){0.f, 0.f};
        h16 pr[4], pk[4], pv[4], pw[4], pa[4];
#define SCAN_ROW(n) ((size_t)b * TPB + (dir == 0 ? (n) : ((n) < CTX ? (CTX - 1 - (n)) : (TPB + CTX - 1 - (n)))))
#define SCAN_LOAD(c) do { _Pragma("unroll") for (int i = 0; i < 4; ++i) { const size_t rr = SCAN_ROW((c) * SCT + wave * 4 + i); \
        pr[i] = R[rr * 1024 + cshared]; pk[i] = Kx[rr * 1024 + cshared]; pv[i] = V[rr * 1024 + cshared]; pw[i] = WP[rr * 2048 + cdir]; pa[i] = AA[rr * 2048 + cdir]; } } while (0)
        SCAN_LOAD(0);
        for (int c = 0; c < TPB / SCT; ++c) {
#pragma unroll
            for (int i = 0; i < 4; ++i) { const int st = wave * 4 + i; const float r = (float)pr[i], k = (float)pk[i], v = (float)pv[i], wp = (float)pw[i], a = (float)pa[i];
                const float dec = __expf(-0.60653065971263342f * __builtin_amdgcn_rcpf(1.0f + __expf(-wp)));
                float kk = k * kkc; float ssq = dpp_red16(kk * kk); ssq += __shfl_xor(ssq, 16); ssq += __shfl_xor(ssq, 32);
                kk = kk * __builtin_amdgcn_rsqf(fmaxf(ssq, 1e-24f));
                const float kd = k * (1.0f + (a - 1.0f) * kac);
                LW[st * 64 + lane] = dec; LA[st * 64 + lane] = -kk; LB[st * 64 + lane] = kk * a; LK[st * 64 + lane] = kd; LR[st * 64 + lane] = r; LV[st * 64 + lane] = v; }
            __syncthreads();
            if (c + 1 < TPB / SCT) SCAN_LOAD(c + 1);
#define SC_LOAD(P, st_) do { const int o_ = (st_) * 64 + ks * 8; \
                P##a0 = *(const LAS f32x4*)(LA + o_); P##a1 = *(const LAS f32x4*)(LA + o_ + 4); P##w0 = *(const LAS f32x4*)(LW + o_); P##w1 = *(const LAS f32x4*)(LW + o_ + 4); \
                P##b0 = *(const LAS f32x4*)(LB + o_); P##b1 = *(const LAS f32x4*)(LB + o_ + 4); P##k0 = *(const LAS f32x4*)(LK + o_); P##k1 = *(const LAS f32x4*)(LK + o_ + 4); \
                P##r0 = *(const LAS f32x4*)(LR + o_); P##r1 = *(const LAS f32x4*)(LR + o_ + 4); P##vv = LV[(st_) * 64 + row]; } while (0)
#define SC_STEP(P, st_) do { \
                const f32x2 t0_ = S[0] * (f32x2){P##a0[0], P##a0[1]} + S[1] * (f32x2){P##a0[2], P##a0[3]}; \
                const f32x2 t1_ = S[2] * (f32x2){P##a1[0], P##a1[1]} + S[3] * (f32x2){P##a1[2], P##a1[3]}; const f32x2 t_ = t0_ + t1_; \
                const float sa = dpp_red8(t_[0] + t_[1]); const f32x2 sa2 = {sa, sa}, v2 = {P##vv, P##vv}; \
                S[0] = S[0] * (f32x2){P##w0[0], P##w0[1]} + (sa2 * (f32x2){P##b0[0], P##b0[1]} + v2 * (f32x2){P##k0[0], P##k0[1]}); \
                S[1] = S[1] * (f32x2){P##w0[2], P##w0[3]} + (sa2 * (f32x2){P##b0[2], P##b0[3]} + v2 * (f32x2){P##k0[2], P##k0[3]}); \
                S[2] = S[2] * (f32x2){P##w1[0], P##w1[1]} + (sa2 * (f32x2){P##b1[0], P##b1[1]} + v2 * (f32x2){P##k1[0], P##k1[1]}); \
                S[3] = S[3] * (f32x2){P##w1[2], P##w1[3]} + (sa2 * (f32x2){P##b1[2], P##b1[3]} + v2 * (f32x2){P##k1[2], P##k1[3]}); \
                const f32x2 y0_ = S[0] * (f32x2){P##r0[0], P##r0[1]} + S[1] * (f32x2){P##r0[2], P##r0[3]}; \
                const f32x2 y1_ = S[2] * (f32x2){P##r1[0], P##r1[1]} + S[3] * (f32x2){P##r1[2], P##r1[3]}; const f32x2 y_ = y0_ + y1_; \
                const float ys = dpp_red8(y_[0] + y_[1]); if (ks == 0) LY[(st_) * 64 + row] = ys; } while (0)
            { f32x4 Aa0, Aa1, Aw0, Aw1, Ab0, Ab1, Ak0, Ak1, Ar0, Ar1, Ba0, Ba1, Bw0, Bw1, Bb0, Bb1, Bk0, Bk1, Br0, Br1; float Avv, Bvv;
              SC_LOAD(A, 0);
#pragma unroll 2
              for (int st = 0; st < SCT; st += 2) {
                  SC_LOAD(B, st + 1);
                  SC_STEP(A, st);
                  if (st + 2 < SCT) SC_LOAD(A, st + 2);
                  SC_STEP(B, st + 1);
              } }
#undef SC_LOAD
#undef SC_STEP
            __syncthreads();
            { const int st = tid >> 4, e0 = (tid & 15) * 4; const size_t rr = SCAN_ROW(c * SCT + st);
              const f32x4 yv = *(const LAS f32x4*)(LY + st * 64 + e0), rv = *(const LAS f32x4*)(LR + st * 64 + e0), kv = *(const LAS f32x4*)(LK + st * 64 + e0), vv4 = *(const LAS f32x4*)(LV + st * 64 + e0);
              const float mean = dpp_red16((yv[0] + yv[1]) + (yv[2] + yv[3])) * (1.0f / 64.0f); const f32x4 dy = yv - mean;
              const float var = dpp_red16((dy[0] * dy[0] + dy[1] * dy[1]) + (dy[2] * dy[2] + dy[3] * dy[3])) * (1.0f / 64.0f);
              const f32x4 rkk = rv * kv * ro_rk; const float bs = dpp_red16((rkk[0] + rkk[1]) + (rkk[2] + rkk[3]));
              const float rstd = 1.0f / sqrtf(var + 64e-5f);
              const f32x4 o = dy * rstd * ro_g + ro_b + vv4 * bs;
              h16x4 hv; hv[0] = (h16)o[0]; hv[1] = (h16)o[1]; hv[2] = (h16)o[2]; hv[3] = (h16)o[3];
              if (do_store) *(h16x4*)(WP + rr * 2048 + (size_t)dir * 1024 + h * 64 + e0) = hv; }
        }
        __syncthreads();
#undef SCAN_LOAD
#undef SCAN_ROW
    }
}
DI void phase0(LAS unsigned char* lds, PP p) {
    FRESH(p); TID_OPAQUE(tid); const size_t gt = (size_t)blockIdx.x * NT + tid, GT = (size_t)gridDim.x * NT;
    { const f32x4* x4 = (const f32x4*)p->in[0]; f32x4* o4 = (f32x4*)p->out; for (size_t i = gt; i < (size_t)NB * SEQ * D / 4; i += GT) o4[i] = x4[i];
      const f32x4* c4 = (const f32x4*)p->in[2]; f32x4* h4 = (f32x4*)(p->ws + OFF_HC); for (size_t i = gt; i < (size_t)NB * CTX * D / 4; i += GT) h4[i] = c4[i]; }
    { float* tda = (float*)(p->ws + OFF_ROPE_DA); for (size_t i = gt; i < (size_t)SEQ * 32; i += GT) { const int sp = (int)(i >> 5), jj = (int)(i & 31), f = jj & 15; const float pos = (float)(jj < 16 ? sp / 64 : sp % 64);
          const float inv = powf(10000.0f, -(float)f / 16.0f), ang = pos * inv; tda[2 * i] = cosf(ang); tda[2 * i + 1] = sinf(ang); }
      float* tgq = (float*)(p->ws + OFF_ROPE_GQ); for (size_t i = gt; i < (size_t)SEQ * 64; i += GT) { const int sp = (int)(i >> 6), jj = (int)(i & 63), f = jj & 31; const float pos = (float)(jj < 32 ? sp / 64 : sp % 64);
          const float inv = powf(10000.0f, -(float)f / 32.0f), ang = pos * inv; tgq[2 * i] = cosf(ang); tgq[2 * i + 1] = sinf(ang); } }
    LAS float* act = (LAS float*)lds;
    float* modp = (float*)(p->ws + OFF_ARENA);
    for (int item = blockIdx.x; item < 4 * 18 * 4; item += gridDim.x) {
        const int ksx = item & 3, cb = (item >> 2) % 18, layer = (item >> 2) / 18, k0 = ksx * 256;
        __syncthreads();
        for (int idx = tid; idx < 256 * 9; idx += NT) { const int k = idx / 9, r = idx % 9; const float cv = r < 8 ? p->in[1][r * 1024 + k0 + k] : p->in[3][k0 + k]; act[k * 12 + r] = cv * sigmoidf_(cv); }
        __syncthreads();
        const int col = cb * 512 + tid; const float* W = p->in[4] + ((size_t)layer * 1024 + k0) * 9216 + col;
        f32x4 a0 = {0.f, 0.f, 0.f, 0.f}, a1 = {0.f, 0.f, 0.f, 0.f}; float a8 = 0.f;
#pragma unroll 8
        for (int k = 0; k < 256; ++k) { const float w = W[(size_t)k * 9216]; a0 += *(const LAS f32x4*)(act + k * 12) * w; a1 += *(const LAS f32x4*)(act + k * 12 + 4) * w; a8 += act[k * 12 + 8] * w; }
        float* dst = modp + ((size_t)(ksx * 4 + layer) * 9) * 9216 + col;
        dst[0] = a0[0]; dst[9216] = a0[1]; dst[2 * 9216] = a0[2]; dst[3 * 9216] = a0[3]; dst[4 * 9216] = a1[0]; dst[5 * 9216] = a1[1]; dst[6 * 9216] = a1[2]; dst[7 * 9216] = a1[3]; dst[8 * 9216] = a8;
    }
    __syncthreads();
}
DI void phase0b(PP p) {
    FRESH(p); TID_OPAQUE(tid); const size_t gt = (size_t)blockIdx.x * NT + tid, GT = (size_t)gridDim.x * NT; const size_t n = (size_t)4 * 9 * 9216;
    const float* modp = (const float*)(p->ws + OFF_ARENA); float* mods = (float*)(p->ws + OFF_MODS);
    for (size_t i = gt; i < n; i += GT) { const int layer = (int)(i / (9 * 9216)), col = (int)(i % 9216); mods[i] = ((modp[i] + modp[n + i]) + (modp[2 * n + i] + modp[3 * n + i])) + p->in[5][layer * 9216 + col]; }
}


DI void gbar(unsigned* ctr, unsigned& target) {
    asm volatile("s_waitcnt vmcnt(0)" ::: "memory");
    __syncthreads();
    target += gridDim.x;
    if (threadIdx.x == 0) {
        __builtin_amdgcn_fence(__ATOMIC_RELEASE, "agent");
        asm volatile("s_waitcnt vmcnt(0)" ::: "memory");
        __hip_atomic_fetch_add(ctr, 1u, __ATOMIC_RELAXED, __HIP_MEMORY_SCOPE_AGENT);
        while (__hip_atomic_load(ctr, __ATOMIC_RELAXED, __HIP_MEMORY_SCOPE_AGENT) < target) __builtin_amdgcn_s_sleep(1);
        __builtin_amdgcn_fence(__ATOMIC_ACQUIRE, "agent");
        asm volatile("s_waitcnt vmcnt(0)" ::: "memory");
    }
    __syncthreads();
}
#define GSYNC() gbar((unsigned*)WSP(OFF_BAR), bar_target)
#ifndef REP_ATT
#define REP_ATT 1
#endif
#ifndef REP_SCAN
#define REP_SCAN 1
#endif
#ifndef REP_FFN
#define REP_FFN 1
#endif
#ifndef REP_P0
#define REP_P0 1
#endif
#ifndef REP_MIX
#define REP_MIX 1
#endif
#ifndef REP_MISC
#define REP_MISC 1
#endif
#define WSP(off) (kp_fresh(kp)->ws + (off))
#define SLABP(i) ((u16*)(kp_fresh(kp)->ws + OFF_ARENA + (size_t)(i) * SLAB))
DI PP kp_fresh(PP q) { FRESH(q); return q; }
DI EpiRes make_res(PP kp, int layer, int gidx, float coef) { PP q = kp_fresh(kp); EpiRes e; e.out = q->out; e.hc = (float*)(q->ws + OFF_HC); e.modl = (const float*)(q->ws + OFF_MODS) + (size_t)layer * 9 * 9216; e.gidx = gidx; e.coef = coef; return e; }
__global__ void __launch_bounds__(512, 2) mega_fwd(Params p_unused) {
    extern __shared__ __attribute__((aligned(16))) unsigned char shm[];
    LAS unsigned char* lds = (LAS unsigned char*)shm;
    cg::grid_group grid = cg::this_grid();
    PP kp = (PP)__builtin_amdgcn_kernarg_segment_ptr();
    unsigned bar_target = 0;

    for (int rep = 0; rep < REP_P0; ++rep) phase0(lds, kp);
    __threadfence(); grid.sync();
    if (PM & 1) phase0b(kp);
    GSYNC();

    for (int layer = 0; layer < 4; ++layer) {
        const int kind = layer % 3, jm = layer / 3;
        for (int sub = 0; sub < 3; ++sub) {
            if (sub != 1) {
                const int which = sub == 0 ? 0 : 1;
                for (int rep = 0; rep < REP_MISC; ++rep) { int tb = 0; conv_ffn(lds, kp, layer, which, tb); if (sub == 0) conv_mixer(lds, kp, layer, tb); }
                for (int rep = 0; rep < REP_MISC; ++rep) phase_modulate(kp, layer, sub == 0 ? 0 : 6, sub == 0 ? 1 : 7, SLABP(0));
                GSYNC();
                for (int rep = 0; rep < REP_FFN; ++rep) { EpiFfn1 e; e.H = SLABP(1); run_gemm(lds, SLABP(0), (const u16*)WSP(OFF_W1T), 5632, 1024, e, layer == 3 && sub == 2); }
                GSYNC();
                for (int rep = 0; rep < REP_FFN; ++rep) { const EpiRes e = make_res(kp, layer, sub == 0 ? 2 : 8, rep == 0 ? 0.5f : 0.0f); run_gemm(lds, SLABP(1), (const u16*)WSP(OFF_W2T), 1024, 2816, e, layer == 3 && sub == 2); }
                GSYNC();
            } else {
                int ao_slab;
                if (kind == 0) {
                    for (int rep = 0; rep < REP_MIX; ++rep) phase_modulate(kp, layer, 3, 4, SLABP(0));
                    GSYNC();
                    for (int rep = 0; rep < REP_MIX; ++rep) { EpiDaQkv e; e.ar = WSP(OFF_ARENA); e.tab = (const float*)WSP(OFF_ROPE_DA); run_gemm(lds, SLABP(0), (const u16*)WSP(OFF_WMIX + WM_QKV), 3072, 1024, e); }
                    GSYNC();
                    for (int rep = 0; rep < REP_MIX; ++rep) transpose_v(lds, SLABP(1), 1024, SLABP(4));
                    GSYNC();
                    for (int rep = 0; rep < REP_ATT; ++rep) attn_phase<2, true>(lds, SLABP(2), SLABP(3), 1024, SLABP(4), 1024, SLABP(0), 2048, 16, layer < 3);
                    GSYNC();
                    for (int rep = 0; rep < REP_MIX; ++rep) combine_da(kp, jm, layer, SLABP(0), SLABP(2));
                    GSYNC();
                    ao_slab = 2;
                } else if (kind == 1) {
                    for (int rep = 0; rep < REP_MIX; ++rep) phase_modulate(kp, layer, 3, 4, SLABP(0));
                    GSYNC();
                    for (int rep = 0; rep < REP_MIX; ++rep) { EpiStore16<1> e; e.ar = WSP(OFF_ARENA); e.col_base = 0; run_gemm(lds, SLABP(0), (const u16*)WSP(OFF_WMIX + WM_QKV), 1536, 1024, e); }
                    GSYNC();
                    qknorm_rope_gq(kp, SLABP(2), SLABP(3)); for (int rep = 0; rep < REP_MIX; ++rep) transpose_v(lds, SLABP(1), 256, SLABP(4));
                    GSYNC();
                    for (int rep = 0; rep < REP_ATT; ++rep) attn_phase<4, false>(lds, SLABP(2), SLABP(3), 256, SLABP(4), 256, SLABP(0), 1024, 8, layer < 3);
                    GSYNC();
                    ao_slab = 0;
                } else {
                    phase_modulate(kp, layer, 3, 4, SLABP(3));
                    GSYNC();
                    phase_mix(kp, SLABP(3), SLABP(0), SLABP(1), SLABP(2), 0, 2, 3);
                    GSYNC();
                    { EpiStore16<2> e; e.ar = WSP(OFF_ARENA); e.col_base = 0; run_gemm(lds, SLABP(0), (const u16*)WSP(OFF_WMIX + WM_QKV), 3072, 1024, e, 0, 2, SLAB); }
                    GSYNC();
                    phase_mix(kp, SLABP(3), SLABP(0), SLABP(1), SLABP(2), 1, 4, 5);
                    GSYNC();
                    { EpiStore16<2> e; e.ar = WSP(OFF_ARENA); e.col_base = 3072; run_gemm(lds, SLABP(0), (const u16*)WSP(OFF_WMIX + WM_QKV) + (size_t)3072 * 1024, 768, 1024, e, 0, 0, SLAB); }
                    GSYNC();
                    for (int rep = 0; rep < REP_MIX; ++rep) { EpiRw2<0> e; e.O = (h16*)SLABP(0); e.bias = kp_fresh(kp)->in[22]; run_gemm(lds, SLABP(7), (const u16*)WSP(OFF_WMIX + WM_RW_W2), 2048, 256, e); }
                    for (int rep = 0; rep < REP_MIX; ++rep) { EpiRw2<1> e; e.O = (h16*)SLABP(2); e.bias = kp_fresh(kp)->in[25]; run_gemm(lds, SLABP(7) + (size_t)M * 256, (const u16*)WSP(OFF_WMIX + WM_RW_A2), 2048, 256, e); }
                    GSYNC();
                    for (int rep = 0; rep < REP_SCAN; ++rep) phase_scan(lds, kp, (const h16*)SLABP(4), (const h16*)SLABP(5), (const h16*)SLABP(6), (h16*)SLABP(0), (const h16*)SLABP(2), rep == REP_SCAN - 1);
                    GSYNC();
                    for (int rep = 0; rep < REP_MIX; ++rep) { EpiRw3 e; e.T = (const h16*)SLABP(0); e.O = SLABP(4); run_gemm(lds, SLABP(7) + (size_t)M * 512, (const u16*)WSP(OFF_WMIX + WM_RW_G2), 2048, 256, e); }
                    GSYNC();
                    ao_slab = 4;
                }
                for (int rep = 0; rep < REP_MIX; ++rep) { const EpiRes e = make_res(kp, layer, 5, rep == 0 ? 1.0f : 0.0f); run_gemm(lds, SLABP(ao_slab), (const u16*)WSP(OFF_WMIX + WM_WO), 1024, 1024, e, layer == 3); }
                GSYNC();
            }
        }
    }
    if (PM & 65536) phase_final(kp);
}

extern "C" void kernel_launch(void* const* d_in, const int* in_sizes, int n_in, void* d_out, int out_size, void* d_ws, size_t ws_size, hipStream_t stream) {
    constexpr size_t kDynLds = 131072;
    static int grid_blocks = 0;
    if (!grid_blocks) {
        int dev = 0, cus = 0, per_cu = 0;
        hipGetDevice(&dev);
        hipDeviceGetAttribute(&cus, hipDeviceAttributeMultiprocessorCount, dev);
        hipFuncSetAttribute((const void*)mega_fwd, hipFuncAttributeMaxDynamicSharedMemorySize, (int)kDynLds);
        hipOccupancyMaxActiveBlocksPerMultiprocessor(&per_cu, (const void*)mega_fwd, NT, kDynLds);
        if (per_cu < 1) per_cu = 1;
        grid_blocks = cus * per_cu;
        if (n_in != 35 || ws_size < WS_NEED) { fprintf(stderr, "kernel_launch: unexpected n_in %d or ws_size %zu < %zu\n", n_in, ws_size, (size_t)WS_NEED); grid_blocks = -1; }
    }
    if (grid_blocks < 0) return;
    Params p{};
    for (int i = 0; i < 35; ++i) p.in[i] = (const float*)d_in[i];
    p.out = (float*)d_out; p.ws = (unsigned char*)d_ws; p.ws_size = ws_size;
    hipMemsetAsync((char*)d_ws + OFF_BAR, 0, 256, stream);
    void* args[] = {&p};
    hipError_t e = hipLaunchCooperativeKernel((void*)mega_fwd, dim3(grid_blocks), dim3(NT), args, kDynLds, stream);
    if (e != hipSuccess) fprintf(stderr, "cooperative launch failed: %s (grid %d)\n", hipGetErrorString(e), grid_blocks);
}
```

```cpp
#include <hip/hip_runtime.h>
#include <hip/hip_cooperative_groups.h>
#include <cstdio>
namespace cg = cooperative_groups;

#define LAS __attribute__((address_space(3)))
#define DI __device__ __forceinline__
typedef unsigned short u16;
typedef short bf16x8 __attribute__((ext_vector_type(8)));
typedef short s16x4 __attribute__((ext_vector_type(4)));
typedef float f32x4 __attribute__((ext_vector_type(4)));
typedef float f32x2 __attribute__((ext_vector_type(2)));
typedef unsigned u32x4 __attribute__((ext_vector_type(4)));
typedef unsigned u32x2 __attribute__((ext_vector_type(2)));
typedef _Float16 h16;
typedef _Float16 h16x4 __attribute__((ext_vector_type(4)));
typedef _Float16 h16x8 __attribute__((ext_vector_type(8)));

constexpr int D = 1024, FF = 2816, NB = 8, SEQ = 4096, CTX = 256, TPB = 4352, M = NB * TPB;
constexpr int NT = 512;
constexpr size_t SLAB = (size_t)M * 1024 * 2;
constexpr size_t OFF_W1T = 0;
constexpr size_t OFF_W2T = OFF_W1T + (size_t)5632 * 1024 * 2;
constexpr size_t OFF_WMIX = OFF_W2T + (size_t)1024 * 2816 * 2;
constexpr size_t OFF_HC = OFF_WMIX + 28835840;
constexpr size_t OFF_MODS = OFF_HC + (size_t)2048 * 1024 * 4;
constexpr size_t OFF_ROPE_DA = OFF_MODS + (size_t)4 * 9 * 9216 * 4;
constexpr size_t OFF_ROPE_GQ = OFF_ROPE_DA + (size_t)4096 * 32 * 8;
constexpr size_t OFF_ARENA = OFF_ROPE_GQ + (size_t)4096 * 64 * 8;
constexpr size_t OFF_BAR = OFF_ARENA + 7 * SLAB + (SLAB / 4) * 3;
constexpr size_t WS_NEED = OFF_BAR + 256;
constexpr size_t WM_QKV = 0;
constexpr size_t WM_RW_W2 = (size_t)3840 * 3072 * 2;
constexpr size_t WM_RW_A2 = WM_RW_W2 + (size_t)2048 * 256 * 2;
constexpr size_t WM_RW_G2 = WM_RW_A2 + (size_t)2048 * 256 * 2;
constexpr size_t WM_WO = WM_RW_G2 + (size_t)2048 * 256 * 2;

#ifndef PM
#define PM 0x1FFFF
#endif
struct Params { const float* in[35]; float* out; unsigned char* ws; size_t ws_size; };
typedef const __attribute__((address_space(4))) Params* PP;
#define FRESH(q) asm volatile("" : "+s"(q))
#define TID_OPAQUE(t) int t = threadIdx.x; asm volatile("" : "+v"(t))

DI float bf2f(u16 v) { return __uint_as_float((unsigned)v << 16); }
typedef __bf16 nbf16x2 __attribute__((ext_vector_type(2)));
DI unsigned pk_bf16(float lo, float hi) { const f32x2 v = {lo, hi}; return __builtin_bit_cast(unsigned, __builtin_convertvector(v, nbf16x2)); }
DI float wave_sum(float v) {
#pragma unroll
    for (int o = 1; o < 64; o <<= 1) v += __shfl_xor(v, o);
    return v;
}
DI float sigmoidf_(float x) { return __builtin_amdgcn_rcpf(1.0f + __expf(-x)); }
DI const float* hrow_c(PP p, int r) { const int b = r / TPB, t = r % TPB; return t < CTX ? (const float*)(p->ws + OFF_HC) + ((size_t)b * CTX + t) * D : p->out + ((size_t)b * SEQ + (t - CTX)) * D; }
DI float* hrow_m(PP p, int r) { const int b = r / TPB, t = r % TPB; return t < CTX ? (float*)(p->ws + OFF_HC) + ((size_t)b * CTX + t) * D : p->out + ((size_t)b * SEQ + (t - CTX)) * D; }

namespace pg8 {
constexpr int BM = 256, BK = 64, HALF = 128, HTB = HALF * BK * 2, STAGE_BYTES = 8 * HTB, NXCD = 1, WGM = 4;
DI int lds_byte(int r, int c) { const int st = (r >> 4) * 2 + (c >> 5), rr = r & 15, cc = c & 31, ob = rr * 64 + cc * 2; return st * 1024 + (ob ^ (((ob >> 9) & 1) << 5)); }
DI void stage_rc(int b, int& R, int& C) { const int st = b / 1024, sb = b % 1024, swz = sb ^ (((sb >> 9) & 1) << 5); R = (st >> 1) * 16 + swz / 64; C = (st & 1) * 32 + (swz % 64) / 2; }
DI int perm32(int rho) { const int n = rho >> 4, i = rho & 15; return 8 * (i >> 2) + 4 * n + (i & 3); }
struct Unit { int pm, pn; };
struct Gemm { const u16* A; const u16* Bt; int M, N, K; int ash; size_t astride; };
struct StaticOrder {
    int nM, nN, nwg, G, c, lat;
    DI void init(int M_, int N_, int G_, int c_, int lat_only) { lat = lat_only; nM = lat_only ? (NB * SEQ) / BM : M_ / BM; nN = N_ / BM; nwg = nM * nN; G = G_; c = c_; }
    DI bool next(int i, Unit& u) const {
        const long L = (long)i * G + c; if (L >= nwg) return false;
        int wgid = (int)L; { const int q = nwg / NXCD, r = nwg % NXCD, xcd = wgid % NXCD, off = wgid / NXCD; wgid = (xcd < r ? xcd * (q + 1) : r * (q + 1) + (xcd - r) * q) + off; }
        const int nig = WGM * nN, gid = wgid / nig, fm = gid * WGM, gsz = (nM - fm) < WGM ? (nM - fm) : WGM;
        u.pm = fm + ((wgid % nig) % gsz); u.pn = (wgid % nig) / gsz; if (lat) u.pm += (u.pm >> 4) + 1; return true;
    }
};
template <class Epi>
DI void gemm_phase(LAS unsigned char* lds, const Gemm g, const StaticOrder& S, const Epi& E) {
    TID_OPAQUE(tid); const int wid = __builtin_amdgcn_readfirstlane(tid >> 6), lane = tid & 63, wr = wid >> 2, wc = wid & 3, fr = lane & 15, fq = lane >> 4;
    const int K = g.K, nt = K / BK;
    unsigned voffA[2], voffB[2];
#pragma unroll
    for (int i = 0; i < 2; ++i) { int R, C; stage_rc(tid * 16 + i * 8192, R, C); const int Rb = Epi::PERM ? ((R & ~31) + perm32(R & 31)) : R;
        voffA[i] = (unsigned)(R * K + C) * 2u; voffB[i] = (unsigned)(Rb * K + C) * 2u; }
    const size_t kstep = (size_t)(BK * 2);
    const size_t hstep = (size_t)HALF * K * 2;
    const size_t tstep = 2 * hstep;
    const unsigned ldsw = (unsigned)wid * 1024u;
    const int aoff = lds_byte(wr * 64 + fr, fq * 8), boff = lds_byte(wc * 32 + fr, fq * 8);
#define PG8_SA(b, h) (((b) * 2 + (h)) * HTB)
#define PG8_SB(b, h) ((4 + (b) * 2 + (h)) * HTB)
#define PG8_STAGE(bufoff, gbase, voff) do { _Pragma("unroll") for (int _i = 0; _i < 2; ++_i) \
        __builtin_amdgcn_global_load_lds((const unsigned*)((const char*)(gbase) + (voff)[_i]), (LAS unsigned*)(lds + (bufoff) + ldsw + _i * 8192), 16, 0, 0); } while (0)
#define PG8_LDA(dst, b, h) do { _Pragma("unroll") for (int m = 0; m < 4; ++m) _Pragma("unroll") for (int k = 0; k < 2; ++k) dst[m][k] = *(const LAS bf16x8*)(lds + PG8_SA(b, h) + aoff + m * 2048 + k * 1024); } while (0)
#define PG8_LDB(dst, b, h) do { _Pragma("unroll") for (int n = 0; n < 2; ++n) _Pragma("unroll") for (int k = 0; k < 2; ++k) dst[n][k] = *(const LAS bf16x8*)(lds + PG8_SB(b, h) + boff + n * 2048 + k * 1024); } while (0)
#define PG8_MMA(ai, bj, At, Bt) do { __builtin_amdgcn_s_setprio(1); _Pragma("unroll") for (int m = 0; m < 4; ++m) _Pragma("unroll") for (int n = 0; n < 2; ++n) _Pragma("unroll") for (int k = 0; k < 2; ++k) \
        acc[ai][bj][m][n] = __builtin_amdgcn_mfma_f32_16x16x32_bf16(Bt[n][k], At[m][k], acc[ai][bj][m][n], 0, 0, 0); __builtin_amdgcn_s_setprio(0); } while (0)
#define PG8_WAIT_V(n) asm volatile("s_waitcnt vmcnt(" #n ")" ::: "memory")
#define PG8_WAIT_L(n) asm volatile("s_waitcnt lgkmcnt(" #n ")" ::: "memory")
#define PG8_BAR __builtin_amdgcn_s_barrier()
#define PG8_SCHED __builtin_amdgcn_sched_barrier(0)
    Unit cur, nxt; int ui = 0;
    if (!S.next(0, cur)) return;
    f32x4 acc[2][2][4][2];
#pragma unroll
    for (int a = 0; a < 2; ++a)
#pragma unroll
        for (int b = 0; b < 2; ++b)
#pragma unroll
            for (int m = 0; m < 4; ++m)
#pragma unroll
                for (int n = 0; n < 2; ++n) acc[a][b][m][n] = (f32x4){0.f, 0.f, 0.f, 0.f};
    bf16x8 At[4][2], B0[2][2], B1[2][2];
    const char* cA = (const char*)g.A + (size_t)(cur.pn >> g.ash) * g.astride + (size_t)cur.pm * tstep; const char* cB = (const char*)g.Bt + (size_t)cur.pn * tstep;
    PG8_STAGE(PG8_SB(0, 0), cB, voffB); PG8_STAGE(PG8_SA(0, 0), cA, voffA); PG8_STAGE(PG8_SB(0, 1), cB + hstep, voffB); PG8_STAGE(PG8_SA(0, 1), cA + hstep, voffA);
    if (wr == 1) PG8_BAR;
    PG8_WAIT_V(4); PG8_BAR;
    PG8_STAGE(PG8_SB(1, 0), cB + kstep, voffB); PG8_STAGE(PG8_SA(1, 0), cA + kstep, voffA); PG8_STAGE(PG8_SB(1, 1), cB + hstep + kstep, voffB);
    PG8_WAIT_V(6); PG8_BAR;
    for (;;) {
        const bool has_next = S.next(ui + 1, nxt);
        const char* nA = has_next ? (const char*)g.A + (size_t)(nxt.pn >> g.ash) * g.astride + (size_t)nxt.pm * tstep : cA; const char* nB = has_next ? (const char*)g.Bt + (size_t)nxt.pn * tstep : cB;
        for (int t = 0; t < nt; t += 2) {
            const bool last = (t == nt - 2);
            const char* a1 = cA + (size_t)(t + 1) * kstep;
            const char* a2 = last ? nA : cA + (size_t)(t + 2) * kstep; const char* b2 = last ? nB : cB + (size_t)(t + 2) * kstep;
            const char* a3 = a2 + kstep; const char* b3 = b2 + kstep;
            PG8_LDB(B0, 0, 0); PG8_SCHED; PG8_LDA(At, 0, 0); PG8_STAGE(PG8_SA(1, 1), a1 + hstep, voffA);
            PG8_WAIT_L(8); PG8_BAR; PG8_WAIT_L(0); PG8_MMA(0, 0, At, B0); PG8_BAR; PG8_SCHED;
            PG8_LDB(B1, 0, 1); PG8_STAGE(PG8_SB(0, 0), b2, voffB);
            PG8_BAR; PG8_WAIT_L(0); PG8_MMA(0, 1, At, B1); PG8_BAR;
            PG8_LDA(At, 0, 1); PG8_STAGE(PG8_SA(0, 0), a2, voffA);
            PG8_BAR; PG8_WAIT_L(0); PG8_MMA(1, 0, At, B0); PG8_BAR; PG8_SCHED;
            PG8_STAGE(PG8_SB(0, 1), b2 + hstep, voffB);
            PG8_WAIT_V(6); PG8_BAR; PG8_MMA(1, 1, At, B1); PG8_BAR;
            PG8_LDB(B0, 1, 0); PG8_SCHED; PG8_LDA(At, 1, 0); PG8_STAGE(PG8_SA(0, 1), a2 + hstep, voffA);
            PG8_WAIT_L(8); PG8_BAR; PG8_WAIT_L(0); PG8_MMA(0, 0, At, B0); PG8_BAR; PG8_SCHED;
            PG8_LDB(B1, 1, 1); PG8_STAGE(PG8_SB(1, 0), b3, voffB);
            PG8_BAR; PG8_WAIT_L(0); PG8_MMA(0, 1, At, B1); PG8_BAR;
            PG8_LDA(At, 1, 1); PG8_STAGE(PG8_SA(1, 0), a3, voffA);
            PG8_BAR; PG8_WAIT_L(0); PG8_MMA(1, 0, At, B0); PG8_BAR; PG8_SCHED;
            PG8_STAGE(PG8_SB(1, 1), b3 + hstep, voffB);
            PG8_WAIT_V(6); PG8_BAR; PG8_MMA(1, 1, At, B1); PG8_BAR;
        }
        E(acc, cur, wr, wc, fr, fq);
        if (!has_next) break;
#pragma unroll
        for (int a = 0; a < 2; ++a)
#pragma unroll
            for (int b = 0; b < 2; ++b)
#pragma unroll
                for (int m = 0; m < 4; ++m)
#pragma unroll
                    for (int n = 0; n < 2; ++n) acc[a][b][m][n] = (f32x4){0.f, 0.f, 0.f, 0.f};
        cur = nxt; cA = nA; cB = nB; ++ui;
    }
    PG8_WAIT_V(0);
    if (wr == 0) PG8_BAR;
    PG8_BAR;
#undef PG8_SA
#undef PG8_SB
#undef PG8_STAGE
#undef PG8_LDA
#undef PG8_LDB
#undef PG8_MMA
#undef PG8_WAIT_V
#undef PG8_WAIT_L
#undef PG8_BAR
#undef PG8_SCHED
}
}
using pg8::Unit;

template <class Epi>
DI void run_gemm(LAS unsigned char* lds, const u16* A, const u16* Bt, int N, int K, const Epi& E, int lat_only = 0, int ash = 30, size_t astride = 0) {
    asm volatile("" : "+s"(K)); asm volatile("" : "+s"(N));
    pg8::StaticOrder S; S.init(M, N, (int)gridDim.x, (int)blockIdx.x, lat_only);
    pg8::Gemm g; g.A = A; g.Bt = Bt; g.M = M; g.N = N; g.K = K; g.ash = ash; g.astride = astride;
    pg8::gemm_phase<Epi>(lds, g, S, E);
    __syncthreads();
}

typedef const f32x4 (&AccRef)[2][2][4][2];
struct EpiRes {
    static constexpr bool PERM = false;
    float* out; float* hc; const float* modl; int gidx; float coef;
    DI void operator()(AccRef acc, const Unit& u, int wr, int wc, int fr, int fq) const {
        const int b = u.pm / 17, tt = u.pm % 17;
        float* hb = tt == 0 ? hc + (size_t)b * CTX * D : out + ((size_t)b * SEQ + (size_t)(tt - 1) * 256) * D;
        const float* g = modl + (size_t)(tt == 0 ? 8 : b) * 9216 + gidx * 1024;
        const int row0 = wr * 64 + fr, col0 = u.pn * 256 + wc * 32 + 4 * fq;
#pragma unroll
        for (int bj = 0; bj < 2; ++bj)
#pragma unroll
            for (int n = 0; n < 2; ++n) { const f32x4 gv = *(const f32x4*)(g + col0 + bj * 128 + n * 16) * coef;
#pragma unroll
                for (int ai = 0; ai < 2; ++ai) {
#pragma unroll
                    for (int m = 0; m < 4; ++m) { f32x4* q = (f32x4*)(hb + (size_t)(row0 + ai * 128 + m * 16) * D + col0 + bj * 128 + n * 16); *q = *q + gv * acc[ai][bj][m][n]; }
                    __builtin_amdgcn_sched_barrier(0); } }
    }
};
struct EpiFfn1 {
    static constexpr bool PERM = true;
    u16* H;
    DI void operator()(AccRef acc, const Unit& u, int wr, int wc, int fr, int fq) const {
        const int row0 = u.pm * 256 + wr * 64 + fr, hcol0 = u.pn * 128 + wc * 32 + 8 * fq;
#pragma unroll
        for (int ai = 0; ai < 2; ++ai)
#pragma unroll
            for (int m = 0; m < 4; ++m) { u16* rowp = H + (size_t)(row0 + ai * 128 + m * 16) * FF + hcol0; float v[8];
#pragma unroll
                for (int n = 0; n < 2; ++n) { const f32x4 gt = acc[ai][0][m][n], up = acc[ai][1][m][n];
#pragma unroll
                    for (int j = 0; j < 4; ++j) v[4 * n + j] = gt[j] * sigmoidf_(gt[j]) * up[j]; }
                u32x4 w; w.x = pk_bf16(v[0], v[1]); w.y = pk_bf16(v[2], v[3]); w.z = pk_bf16(v[4], v[5]); w.w = pk_bf16(v[6], v[7]); __builtin_nontemporal_store(w, (u32x4*)rowp);
                __builtin_amdgcn_sched_barrier(0); }
    }
};
template <int MODE> struct EpiStore16 {
    static constexpr bool PERM = true;
    unsigned char* ar;
    int col_base;
    DI void operator()(AccRef acc, const Unit& u, int wr, int wc, int fr, int fq) const {
        int colt = u.pn * 256 + (MODE == 2 ? col_base : 0); size_t boff; int ldc; int act = 0;
        float qs = 1.0f;
        if (MODE == 0) { const int rg = colt >> 10; boff = (size_t)((rg + 1) % 3 + 1) * SLAB; ldc = 1024; colt &= 1023; if (rg == 0) qs = 0.125f * 1.4426950408889634f; }
        else if (MODE == 1) { if (colt < 1024) { boff = 2 * SLAB; ldc = 1024; } else if (colt < 1280) { boff = 3 * SLAB; ldc = 256; colt -= 1024; } else { boff = SLAB; ldc = 256; colt -= 1280; } }
        else { if (colt < 3072) { const int rg = colt >> 10; boff = (size_t)(4 + rg) * SLAB; ldc = 1024; colt &= 1023; act = 1; }
               else { const int idx = (colt - 3072) >> 8; boff = 7 * SLAB + (size_t)idx * M * 256 * 2; ldc = 256; colt = 0; act = idx == 0 ? 2 : (idx == 1 ? 0 : 3); } }
        u16* base = (u16*)(ar + boff);
        const int row0 = u.pm * 256 + wr * 64 + fr, col0 = colt + wc * 32 + 8 * fq;
#pragma unroll
        for (int ai = 0; ai < 2; ++ai)
#pragma unroll
            for (int m = 0; m < 4; ++m) { u16* rowp = base + (size_t)(row0 + ai * 128 + m * 16) * ldc + col0;
#pragma unroll
                for (int bj = 0; bj < 2; ++bj) { f32x4 v0 = acc[ai][bj][m][0], v1 = acc[ai][bj][m][1];
                    if (MODE == 0) { v0 = v0 * qs; v1 = v1 * qs; }
                    if (act == 1) { h16x8 hv; hv[0] = (h16)v0[0]; hv[1] = (h16)v0[1]; hv[2] = (h16)v0[2]; hv[3] = (h16)v0[3]; hv[4] = (h16)v1[0]; hv[5] = (h16)v1[1]; hv[6] = (h16)v1[2]; hv[7] = (h16)v1[3];
                        *(h16x8*)(rowp + bj * 128) = hv; }
                    else {
                        if (act == 2) {
#pragma unroll
                            for (int j = 0; j < 4; ++j) { v0[j] = 1.0f - 2.0f * __builtin_amdgcn_rcpf(1.0f + __expf(2.0f * v0[j])); v1[j] = 1.0f - 2.0f * __builtin_amdgcn_rcpf(1.0f + __expf(2.0f * v1[j])); } }
                        if (act == 3) {
#pragma unroll
                            for (int j = 0; j < 4; ++j) { v0[j] = sigmoidf_(v0[j]); v1[j] = sigmoidf_(v1[j]); } }
                        u32x4 w; w.x = pk_bf16(v0[0], v0[1]); w.y = pk_bf16(v0[2], v0[3]); w.z = pk_bf16(v1[0], v1[1]); w.w = pk_bf16(v1[2], v1[3]);
                        *(u32x4*)(rowp + bj * 128) = w; } __builtin_amdgcn_sched_barrier(0); } }
    }
};
struct EpiDaQkv {
    static constexpr bool PERM = true;
    unsigned char* ar; const float* tab;
    DI void operator()(AccRef acc, const Unit& u, int wr, int wc, int fr, int fq) const {
        const int colt = u.pn * 256, rg = colt >> 10, tt = u.pm % 17;
        u16* base = (u16*)(ar + (size_t)((rg + 1) % 3 + 1) * SLAB);
        const int row0 = u.pm * 256 + wr * 64 + fr;
        if (rg == 2) {
            const int col0 = (colt & 1023) + wc * 32 + 8 * fq;
#pragma unroll
            for (int ai = 0; ai < 2; ++ai)
#pragma unroll
                for (int m = 0; m < 4; ++m) { u16* rowp = base + (size_t)(row0 + ai * 128 + m * 16) * 1024 + col0;
#pragma unroll
                    for (int bj = 0; bj < 2; ++bj) { const f32x4 v0 = acc[ai][bj][m][0], v1 = acc[ai][bj][m][1];
                        u32x4 w; w.x = pk_bf16(v0[0], v0[1]); w.y = pk_bf16(v0[2], v0[3]); w.z = pk_bf16(v1[0], v1[1]); w.w = pk_bf16(v1[2], v1[3]); *(u32x4*)(rowp + bj * 128) = w; }
                    __builtin_amdgcn_sched_barrier(0); }
            return;
        }
        const float qs = rg == 0 ? 0.125f * 1.4426950408889634f : 1.0f;
        const int col0 = (colt & 1023) + 64 * wc + 8 * fq;
#pragma unroll
        for (int ai = 0; ai < 2; ++ai)
#pragma unroll
            for (int m = 0; m < 4; ++m) { const int lr = ai * 128 + wr * 64 + m * 16 + fr; u16* rowp = base + (size_t)(row0 + ai * 128 + m * 16) * 1024 + col0;
                float x1[8], x2[8], o1[8], o2[8];
#pragma unroll
                for (int n = 0; n < 2; ++n)
#pragma unroll
                    for (int j = 0; j < 4; ++j) { x1[4 * n + j] = acc[ai][0][m][n][j] * qs; x2[4 * n + j] = acc[ai][1][m][n][j] * qs; }
                if (tt != 0) { const float* tb = tab + ((size_t)((tt - 1) * 256 + lr) * 32 + 8 * fq) * 2;
#pragma unroll
                    for (int q_ = 0; q_ < 4; ++q_) { const f32x4 cs = *(const f32x4*)(tb + 4 * q_);
                        o1[2 * q_] = x1[2 * q_] * cs[0] - x2[2 * q_] * cs[1]; o2[2 * q_] = x2[2 * q_] * cs[0] + x1[2 * q_] * cs[1];
                        o1[2 * q_ + 1] = x1[2 * q_ + 1] * cs[2] - x2[2 * q_ + 1] * cs[3]; o2[2 * q_ + 1] = x2[2 * q_ + 1] * cs[2] + x1[2 * q_ + 1] * cs[3]; } }
                else {
#pragma unroll
                    for (int j = 0; j < 8; ++j) { o1[j] = x1[j]; o2[j] = x2[j]; } }
                u32x4 w1, w2; w1.x = pk_bf16(o1[0], o1[1]); w1.y = pk_bf16(o1[2], o1[3]); w1.z = pk_bf16(o1[4], o1[5]); w1.w = pk_bf16(o1[6], o1[7]);
                w2.x = pk_bf16(o2[0], o2[1]); w2.y = pk_bf16(o2[2], o2[3]); w2.z = pk_bf16(o2[4], o2[5]); w2.w = pk_bf16(o2[6], o2[7]);
                *(u32x4*)rowp = w1; *(u32x4*)(rowp + 32) = w2;
                __builtin_amdgcn_sched_barrier(0); }
    }
};
template <int SIG> struct EpiRw2 {
    static constexpr bool PERM = true;
    h16* O; const float* bias;
    DI void operator()(AccRef acc, const Unit& u, int wr, int wc, int fr, int fq) const {
        const int row0 = u.pm * 256 + wr * 64 + fr, col0 = u.pn * 256 + wc * 32 + 8 * fq;
        f32x4 bv[2][2];
#pragma unroll
        for (int bj = 0; bj < 2; ++bj)
#pragma unroll
            for (int n = 0; n < 2; ++n) bv[bj][n] = *(const f32x4*)(bias + col0 + bj * 128 + 4 * n);
#pragma unroll
        for (int ai = 0; ai < 2; ++ai)
#pragma unroll
            for (int m = 0; m < 4; ++m) { h16* rowp = O + (size_t)(row0 + ai * 128 + m * 16) * 2048 + col0;
#pragma unroll
                for (int bj = 0; bj < 2; ++bj) { f32x4 v0 = acc[ai][bj][m][0] + bv[bj][0], v1 = acc[ai][bj][m][1] + bv[bj][1];
                    if (SIG) {
#pragma unroll
                        for (int j = 0; j < 4; ++j) { v0[j] = sigmoidf_(v0[j]); v1[j] = sigmoidf_(v1[j]); } }
                    h16x8 hv; hv[0] = (h16)v0[0]; hv[1] = (h16)v0[1]; hv[2] = (h16)v0[2]; hv[3] = (h16)v0[3]; hv[4] = (h16)v1[0]; hv[5] = (h16)v1[1]; hv[6] = (h16)v1[2]; hv[7] = (h16)v1[3];
                    *(h16x8*)(rowp + bj * 128) = hv; __builtin_amdgcn_sched_barrier(0); } }
    }
};
struct EpiRw3 {
    static constexpr bool PERM = false;
    const h16* T; u16* O;
    DI void operator()(AccRef acc, const Unit& u, int wr, int wc, int fr, int fq) const {
        const int row0 = u.pm * 256 + wr * 64 + fr, hcol0 = u.pn * 128 + wc * 16 + 4 * fq;
#pragma unroll
        for (int ai = 0; ai < 2; ++ai)
#pragma unroll
            for (int m = 0; m < 4; ++m) { const size_t row = (size_t)(row0 + ai * 128 + m * 16);
#pragma unroll
                for (int bj = 0; bj < 2; ++bj) { const int hc = hcol0 + bj * 64;
                    const h16x4 t0 = *(const h16x4*)(T + row * 2048 + hc), t1 = *(const h16x4*)(T + row * 2048 + 1024 + hc);
                    const f32x4 g0 = acc[ai][bj][m][0], g1 = acc[ai][bj][m][1]; float v[4];
#pragma unroll
                    for (int j = 0; j < 4; ++j) v[j] = (float)t0[j] * g0[j] + (float)t1[j] * g1[j];
                    u32x2 w; w.x = pk_bf16(v[0], v[1]); w.y = pk_bf16(v[2], v[3]); *(u32x2*)(O + row * 1024 + hc) = w; __builtin_amdgcn_sched_barrier(0); } }
    }
};

template <int KIND>
DI float wsrc_val(const float* s0, const float* s1, const float* s2, const float* s3, const float* s4, const float* s5, const float* mu, int ldn, int n, int k) {
    if (KIND == 0) return s0[(size_t)k * ldn + n];
    if (KIND == 1) { const int pn = n >> 8, cl = n & 255, kindg = cl >> 7, hid = 128 * pn + (cl & 127); return kindg ? s1[(size_t)k * FF + hid] : s0[(size_t)k * FF + hid]; }
    if (KIND == 2) {
        const int seg = k >> 10, kk = k & 1023; float val; int mi;
        if (n < 1024) { val = s0[(size_t)kk * 1024 + n]; mi = 0; }
        else if (n < 2048) { val = s1[(size_t)kk * 1024 + (n - 1024)]; mi = 2; }
        else if (n < 3072) { val = s2[(size_t)kk * 1024 + (n - 2048)]; mi = 3; }
        else if (n < 3328) { const int j = n - 3072; if (j >= 128) return 0.f; val = s3[((size_t)(j >> 6) * 1024 + kk) * 64 + (j & 63)]; mi = 1; }
        else if (n < 3584) { const int j = n - 3328; if (j >= 128) return 0.f; val = s4[((size_t)(j >> 6) * 1024 + kk) * 64 + (j & 63)]; mi = 4; }
        else { const int j = n - 3584; val = s5[((size_t)(j >> 7) * 1024 + kk) * 128 + (j & 127)]; mi = 5; }
        const float m0 = mu[(0 * 6 + mi) * 1024 + kk], m1 = mu[(1 * 6 + mi) * 1024 + kk];
        const float coef = seg == 0 ? 1.f - m0 - m1 : (seg == 1 ? m0 : m1);
        return coef * val;
    }
    if (KIND == 7) { int orig = n; if (n < 2048) { const int cl = n & 255; orig = (n & ~255) + 64 * ((cl >> 5) & 3) + 32 * (cl >> 7) + (cl & 31); } return s0[(size_t)k * 3072 + orig]; }
    if (KIND == 5) { if (n >= 128) return 0.f; return s0[((size_t)(n >> 6) * 1024 + k) * 64 + (n & 63)]; }
    if (KIND == 6) { return s0[((size_t)(n >> 7) * 1024 + k) * 128 + (n & 127)]; }
    if (KIND == 3) { const int d = n >> 10, col = n & 1023; if (k >= 128 || (k >> 6) != d) return 0.f; return s0[((size_t)d * 64 + (k & 63)) * 1024 + col]; }
    { const int pn = n >> 8, c = n & 255, bj = c >> 7, wc = (c & 127) >> 5, dir = (c & 31) >> 4, rest = c & 15, hcol = pn * 128 + bj * 64 + wc * 16 + rest;
      if ((k >> 7) != dir) return 0.f; return s0[((size_t)dir * 128 + (k & 127)) * 1024 + hcol]; }
}
template <int KIND>
DI void conv_tiles(LAS unsigned char* lds, const float* s0, const float* s1, const float* s2, const float* s3, const float* s4, const float* s5, const float* mu, int ldn, u16* dst, int N, int K, int& tbase) {
    LAS float* s = (LAS float*)lds;
    TID_OPAQUE(tid); const int nk = K / 64, ntile = (N / 64) * nk, gsz = gridDim.x;
    const int first = ((int)blockIdx.x - (tbase % gsz) + gsz) % gsz;
    for (int t = first; t < ntile; t += gsz) {
        const int n0 = (t / nk) * 64, k0 = (t % nk) * 64;
        __syncthreads();
#pragma unroll
        for (int i = 0; i < 8; ++i) { const int kl = (tid >> 6) + 8 * i, nl = tid & 63; s[kl * 65 + nl] = wsrc_val<KIND>(s0, s1, s2, s3, s4, s5, mu, ldn, n0 + nl, k0 + kl); }
        __syncthreads();
        const int nl = tid >> 3, kc = tid & 7;
        u32x4 o; o.x = pk_bf16(s[(kc * 8 + 0) * 65 + nl], s[(kc * 8 + 1) * 65 + nl]); o.y = pk_bf16(s[(kc * 8 + 2) * 65 + nl], s[(kc * 8 + 3) * 65 + nl]);
        o.z = pk_bf16(s[(kc * 8 + 4) * 65 + nl], s[(kc * 8 + 5) * 65 + nl]); o.w = pk_bf16(s[(kc * 8 + 6) * 65 + nl], s[(kc * 8 + 7) * 65 + nl]);
        *(u32x4*)(dst + (size_t)(n0 + nl) * K + k0 + kc * 8) = o;
    }
    tbase += ntile;
}
DI void conv_ffn(LAS unsigned char* lds, PP p, int layer, int which, int& tb) {
    FRESH(p);
    const float* z = nullptr;
    conv_tiles<1>(lds, p->in[6] + ((size_t)layer * 2 + which) * D * FF, p->in[7] + ((size_t)layer * 2 + which) * D * FF, z, z, z, z, z, 0, (u16*)(p->ws + OFF_W1T), 5632, 1024, tb);
    conv_tiles<0>(lds, p->in[8] + ((size_t)layer * 2 + which) * FF * D, z, z, z, z, z, z, 1024, (u16*)(p->ws + OFF_W2T), 1024, 2816, tb);
}
DI void conv_mixer(LAS unsigned char* lds, PP p, int layer, int& tb) {
    FRESH(p);
    const int kind = layer % 3, j = layer / 3; const float* z = nullptr;
    unsigned char* wm = p->ws + OFF_WMIX;
    if (kind == 0) {
        conv_tiles<7>(lds, p->in[10] + (size_t)j * D * 3072, z, z, z, z, z, z, 3072, (u16*)(wm + WM_QKV), 3072, 1024, tb);
        conv_tiles<0>(lds, p->in[11] + (size_t)j * D * D, z, z, z, z, z, z, 1024, (u16*)(wm + WM_WO), 1024, 1024, tb);
    } else if (kind == 1) {
        conv_tiles<0>(lds, p->in[14], z, z, z, z, z, z, 1536, (u16*)(wm + WM_QKV), 1536, 1024, tb);
        conv_tiles<0>(lds, p->in[15], z, z, z, z, z, z, 1024, (u16*)(wm + WM_WO), 1024, 1024, tb);
    } else {
        conv_tiles<0>(lds, p->in[18], z, z, z, z, z, z, 1024, (u16*)(wm + WM_QKV), 1024, 1024, tb);
        conv_tiles<0>(lds, p->in[19], z, z, z, z, z, z, 1024, (u16*)(wm + WM_QKV) + (size_t)1024 * 1024, 1024, 1024, tb);
        conv_tiles<0>(lds, p->in[20], z, z, z, z, z, z, 1024, (u16*)(wm + WM_QKV) + (size_t)2048 * 1024, 1024, 1024, tb);
        conv_tiles<5>(lds, p->in[23], z, z, z, z, z, z, 0, (u16*)(wm + WM_QKV) + (size_t)3072 * 1024, 256, 1024, tb);
        conv_tiles<5>(lds, p->in[26], z, z, z, z, z, z, 0, (u16*)(wm + WM_QKV) + (size_t)3328 * 1024, 256, 1024, tb);
        conv_tiles<6>(lds, p->in[28], z, z, z, z, z, z, 0, (u16*)(wm + WM_QKV) + (size_t)3584 * 1024, 256, 1024, tb);
        conv_tiles<3>(lds, p->in[24], z, z, z, z, z, z, 0, (u16*)(wm + WM_RW_W2), 2048, 256, tb);
        conv_tiles<3>(lds, p->in[27], z, z, z, z, z, z, 0, (u16*)(wm + WM_RW_A2), 2048, 256, tb);
        conv_tiles<4>(lds, p->in[29], z, z, z, z, z, z, 0, (u16*)(wm + WM_RW_G2), 2048, 256, tb);
        conv_tiles<0>(lds, p->in[21], z, z, z, z, z, z, 1024, (u16*)(wm + WM_WO), 1024, 1024, tb);
    }
}

DI void phase_modulate(PP p, int layer, int shi, int sci, u16* XN) {
    FRESH(p); TID_OPAQUE(tid_); const int lane = tid_ & 63, gw = blockIdx.x * 8 + (tid_ >> 6), NW = gridDim.x * 8;
    const float* mods = (const float*)(p->ws + OFF_MODS) + (size_t)layer * 9 * 9216;
    for (int r = gw; r < M; r += NW) {
        const float* hr = hrow_c(p, r); const int b = r / TPB, t = r % TPB;
        const float* md = mods + (size_t)(t < CTX ? 8 : b) * 9216;
        f32x4 v[4]; float s = 0.f;
#pragma unroll
        for (int j = 0; j < 4; ++j) { v[j] = *(const f32x4*)(hr + 4 * lane + 256 * j); s += v[j][0] * v[j][0] + v[j][1] * v[j][1] + v[j][2] * v[j][2] + v[j][3] * v[j][3]; }
        s = wave_sum(s); const float rstd = 1.0f / sqrtf(s * (1.0f / 1024.0f) + 1e-6f);
#pragma unroll
        for (int j = 0; j < 4; ++j) { const int col = 4 * lane + 256 * j; const f32x4 sc = *(const f32x4*)(md + sci * 1024 + col), sh = *(const f32x4*)(md + shi * 1024 + col);
            const f32x4 o = v[j] * rstd * (sc + 1.0f) + sh; u32x2 w; w.x = pk_bf16(o[0], o[1]); w.y = pk_bf16(o[2], o[3]); *(u32x2*)(XN + (size_t)r * 1024 + col) = w; }
    }
}
DI f32x4 bf4_to_f32(u32x2 v) { f32x4 o; o[0] = __uint_as_float(v.x << 16); o[1] = __uint_as_float(v.x & 0xffff0000u); o[2] = __uint_as_float(v.y << 16); o[3] = __uint_as_float(v.y & 0xffff0000u); return o; }
DI void phase_mix(PP p, const u16* U, u16* O0, u16* O1, u16* O2, int i0, int i1, int i2) {
    FRESH(p); TID_OPAQUE(tid_); const int lane = tid_ & 63, gw = blockIdx.x * 8 + (tid_ >> 6), NW = gridDim.x * 8;
    const float* mu = p->in[17];
    const int rpw = (M + NW - 1) / NW;
    const int r0 = gw * rpw, r1 = (r0 + rpw < M) ? r0 + rpw : M;
    if (r0 >= M) return;
#pragma unroll 1
    for (int j = 0; j < 4; ++j) { const int col = 4 * lane + 256 * j;
        const f32x4 p0 = *(const f32x4*)(mu + (size_t)i0 * 1024 + col), n0 = *(const f32x4*)(mu + (size_t)(6 + i0) * 1024 + col);
        const f32x4 p1 = *(const f32x4*)(mu + (size_t)i1 * 1024 + col), n1 = *(const f32x4*)(mu + (size_t)(6 + i1) * 1024 + col);
        const f32x4 p2 = *(const f32x4*)(mu + (size_t)i2 * 1024 + col), n2 = *(const f32x4*)(mu + (size_t)(6 + i2) * 1024 + col);
        f32x4 cur = bf4_to_f32(*(const u32x2*)(U + (size_t)r0 * 1024 + col));
        f32x4 prev = (r0 > 0) ? bf4_to_f32(*(const u32x2*)(U + (size_t)(r0 - 1) * 1024 + col)) : (f32x4){0.f, 0.f, 0.f, 0.f};
#pragma unroll 1
        for (int r = r0; r < r1; ++r) {
            const int t = r % TPB; const bool first = (t == 0) || (t == CTX), last = (t == CTX - 1) || (t == TPB - 1);
            const f32x4 nx = (r + 1 < M) ? bf4_to_f32(*(const u32x2*)(U + (size_t)(r + 1) * 1024 + col)) : (f32x4){0.f, 0.f, 0.f, 0.f};
            const f32x4 z4 = {0.f, 0.f, 0.f, 0.f};
            const f32x4 dp = (first ? z4 : prev) - cur, dn = (last ? z4 : nx) - cur;
            { const f32x4 o = cur + dp * p0 + dn * n0; u32x2 w; w.x = pk_bf16(o[0], o[1]); w.y = pk_bf16(o[2], o[3]); *(u32x2*)(O0 + (size_t)r * 1024 + col) = w; }
            { const f32x4 o = cur + dp * p1 + dn * n1; u32x2 w; w.x = pk_bf16(o[0], o[1]); w.y = pk_bf16(o[2], o[3]); *(u32x2*)(O1 + (size_t)r * 1024 + col) = w; }
            { const f32x4 o = cur + dp * p2 + dn * n2; u32x2 w; w.x = pk_bf16(o[0], o[1]); w.y = pk_bf16(o[2], o[3]); *(u32x2*)(O2 + (size_t)r * 1024 + col) = w; }
            prev = cur; cur = nx;
        }
    }
}
DI void transpose_v(LAS unsigned char* lds, const u16* V, int vcols, u16* VT) {
    LAS u16* s = (LAS u16*)lds;
    TID_OPAQUE(tid); const int nct = vcols / 64, ntile = (M / 64) * nct;
    for (int t = blockIdx.x; t < ntile; t += gridDim.x) {
        const int r0 = (t / nct) * 64, c0 = (t % nct) * 64, b = r0 / TPB, t0 = r0 % TPB;
        __syncthreads();
        { const int tr = tid >> 3, cc = tid & 7; *(LAS u32x4*)(s + tr * 72 + cc * 8) = *(const u32x4*)(V + (size_t)(r0 + tr) * vcols + c0 + cc * 8); }
        __syncthreads();
        { const int col = tid >> 3, tc = tid & 7; u16 e[8];
#pragma unroll
          for (int j = 0; j < 8; ++j) e[j] = s[(tc * 8 + j) * 72 + col];
          u32x4 o; o.x = e[0] | ((unsigned)e[1] << 16); o.y = e[2] | ((unsigned)e[3] << 16); o.z = e[4] | ((unsigned)e[5] << 16); o.w = e[6] | ((unsigned)e[7] << 16);
          *(u32x4*)(VT + ((size_t)b * vcols + c0 + col) * TPB + t0 + tc * 8) = o; }
    }
}
DI void rope_da(PP p, u16* Q, u16* K) {
    FRESH(p); TID_OPAQUE(tid_); const int lane = tid_ & 63, gw = blockIdx.x * 8 + (tid_ >> 6), NW = gridDim.x * 8;
    const float* tab = (const float*)(p->ws + OFF_ROPE_DA);
    const int N = 2 * NB * SEQ;
    for (int i = gw; i < N; i += 2 * NW) {
        u16* base[2]; const float* tb[2]; u32x4 a[2], c[2]; f32x4 cs[2][4]; bool ok[2];
#pragma unroll
        for (int u = 0; u < 2; ++u) { const int ii = i + u * NW; ok[u] = ii < N; const int iv = ok[u] ? ii : i;
            const int which = iv & 1, lr = iv >> 1, b = lr / SEQ, sp = lr % SEQ; const size_t r = (size_t)b * TPB + CTX + sp;
            base[u] = (which ? K : Q) + r * 1024 + (lane >> 2) * 64 + (lane & 3) * 8; tb[u] = tab + ((size_t)sp * 32 + (lane & 3) * 8) * 2;
            a[u] = *(const u32x4*)base[u]; c[u] = *(const u32x4*)(base[u] + 32);
#pragma unroll
            for (int j = 0; j < 4; ++j) cs[u][j] = *(const f32x4*)(tb[u] + 4 * j); }
#pragma unroll
        for (int u = 0; u < 2; ++u) { if (!ok[u]) continue; u32x4 oa, oc;
#pragma unroll
            for (int j = 0; j < 4; ++j) {
                const float x1a = __uint_as_float(a[u][j] << 16), x1b = __uint_as_float(a[u][j] & 0xffff0000u), x2a = __uint_as_float(c[u][j] << 16), x2b = __uint_as_float(c[u][j] & 0xffff0000u);
                oa[j] = pk_bf16(x1a * cs[u][j][0] - x2a * cs[u][j][1], x1b * cs[u][j][2] - x2b * cs[u][j][3]); oc[j] = pk_bf16(x2a * cs[u][j][0] + x1a * cs[u][j][1], x2b * cs[u][j][2] + x1b * cs[u][j][3]); }
            *(u32x4*)base[u] = oa; *(u32x4*)(base[u] + 32) = oc; }
    }
}
DI void qknorm_rope_gq(PP p, u16* Q, u16* K) {
    FRESH(p); TID_OPAQUE(tid_); const int lane = tid_ & 63, gw = blockIdx.x * 8 + (tid_ >> 6), NW = gridDim.x * 8;
    const float* tab = (const float*)(p->ws + OFF_ROPE_GQ); const float* gq = p->in[16];
    for (int r = gw; r < M; r += NW) {
        const int t = r % TPB; const bool lat = t >= CTX; const int sp = lat ? t - CTX : 0;
        const int hd = lane >> 3, j0 = (lane & 7) * 8;
#pragma unroll
        for (int which = 0; which < 2; ++which) {
            if (which == 1 && hd >= 2) continue;
            const float qsc = which == 0 ? 0.08838834764831845f * 1.4426950408889634f : 1.0f;
            u16* base = (which ? K + (size_t)r * 256 : Q + (size_t)r * 1024) + hd * 128 + j0; const float* g = gq + which * 128;
            const u32x4 a = *(const u32x4*)base, c = *(const u32x4*)(base + 64);
            float x1[8], x2[8]; float ss = 0.f;
#pragma unroll
            for (int j = 0; j < 4; ++j) { x1[2 * j] = __uint_as_float(a[j] << 16); x1[2 * j + 1] = __uint_as_float(a[j] & 0xffff0000u); x2[2 * j] = __uint_as_float(c[j] << 16); x2[2 * j + 1] = __uint_as_float(c[j] & 0xffff0000u); }
#pragma unroll
            for (int j = 0; j < 8; ++j) ss += x1[j] * x1[j] + x2[j] * x2[j];
            ss += __shfl_xor(ss, 1); ss += __shfl_xor(ss, 2); ss += __shfl_xor(ss, 4);
            const float rstd = 1.0f / sqrtf(ss * (1.0f / 128.0f) + 1e-6f);
            float o1[8], o2[8];
#pragma unroll
            for (int j = 0; j < 8; ++j) { const float y1 = x1[j] * rstd * g[j0 + j], y2 = x2[j] * rstd * g[64 + j0 + j];
                float cs = 1.f, sn = 0.f; if (lat) { cs = tab[((size_t)sp * 64 + j0 + j) * 2]; sn = tab[((size_t)sp * 64 + j0 + j) * 2 + 1]; }
                o1[j] = (y1 * cs - y2 * sn) * qsc; o2[j] = (y2 * cs + y1 * sn) * qsc; }
            u32x4 oa, oc;
#pragma unroll
            for (int j = 0; j < 4; ++j) { oa[j] = pk_bf16(o1[2 * j], o1[2 * j + 1]); oc[j] = pk_bf16(o2[2 * j], o2[2 * j + 1]); }
            *(u32x4*)base = oa; *(u32x4*)(base + 64) = oc;
        }
    }
}
DI void combine_da(PP p, int j, int layer, const u16* O, u16* OUT) {
    asm volatile("" : "+s"(layer));
    const float lam_init = layer == 0 ? 0.2f : 0.55605820416f;
    FRESH(p); TID_OPAQUE(tid_); const int lane = tid_ & 63, gw = blockIdx.x * 8 + (tid_ >> 6), NW = gridDim.x * 8;
    const float* lv = p->in[12] + (size_t)j * 256; const float* sg = p->in[13] + (size_t)j * 128;
    const float lam = expf(wave_sum(lv[lane] * lv[64 + lane])) - expf(wave_sum(lv[128 + lane] * lv[192 + lane])) + lam_init;
    const int hd = lane >> 3, d0 = (lane & 7) * 16;
    for (int r = gw; r < M; r += NW) {
        const u16* o0 = O + (size_t)r * 2048 + (2 * hd) * 128 + d0; const u16* o1 = o0 + 128;
        float v[16]; float ss = 0.f;
#pragma unroll
        for (int q = 0; q < 2; ++q) { const u32x4 a = *(const u32x4*)(o0 + 8 * q), c = *(const u32x4*)(o1 + 8 * q);
#pragma unroll
            for (int jj = 0; jj < 4; ++jj) { v[8 * q + 2 * jj] = __uint_as_float(a[jj] << 16) - lam * __uint_as_float(c[jj] << 16); v[8 * q + 2 * jj + 1] = __uint_as_float(a[jj] & 0xffff0000u) - lam * __uint_as_float(c[jj] & 0xffff0000u); } }
#pragma unroll
        for (int q = 0; q < 16; ++q) ss += v[q] * v[q];
        ss += __shfl_xor(ss, 1); ss += __shfl_xor(ss, 2); ss += __shfl_xor(ss, 4);
        const float sc = (1.0f - lam_init) / sqrtf(ss * (1.0f / 128.0f) + 1e-6f);
        u32x4 w0, w1;
#pragma unroll
        for (int jj = 0; jj < 4; ++jj) { w0[jj] = pk_bf16(v[2 * jj] * sc * sg[d0 + 2 * jj], v[2 * jj + 1] * sc * sg[d0 + 2 * jj + 1]); w1[jj] = pk_bf16(v[8 + 2 * jj] * sc * sg[d0 + 8 + 2 * jj], v[8 + 2 * jj + 1] * sc * sg[d0 + 8 + 2 * jj + 1]); }
        u16* dst = OUT + (size_t)r * 1024 + hd * 128 + d0; *(u32x4*)dst = w0; *(u32x4*)(dst + 8) = w1;
    }
}
DI void phase_final(PP p) {
    FRESH(p); TID_OPAQUE(tid_); const int lane = tid_ & 63, gw = blockIdx.x * 8 + (tid_ >> 6), NW = gridDim.x * 8; const float* fg = p->in[9];
    for (int r = gw; r < NB * SEQ; r += NW) {
        float* hr = p->out + (size_t)r * D; f32x4 v[4]; float s = 0.f;
#pragma unroll
        for (int j = 0; j < 4; ++j) { v[j] = *(const f32x4*)(hr + 4 * lane + 256 * j); s += v[j][0] * v[j][0] + v[j][1] * v[j][1] + v[j][2] * v[j][2] + v[j][3] * v[j][3]; }
        s = wave_sum(s); const float rstd = 1.0f / sqrtf(s * (1.0f / 1024.0f) + 1e-6f);
#pragma unroll
        for (int j = 0; j < 4; ++j) { const int col = 4 * lane + 256 * j; f32x4 o = v[j] * rstd * *(const f32x4*)(fg + col);
#ifdef SCRUB
            for (int q = 0; q < 4; ++q) if (!(fabsf(o[q]) < 1e30f)) o[q] = 1000.0f;
#endif
            *(f32x4*)(hr + col) = o; }
    }
}

template <int KS, bool DA>
DI void attn_phase(LAS unsigned char* lds, const u16* Q, const u16* K, int ldk, const u16* VT, int vtr, u16* O, int ldo, int NH) {
    constexpr int DQK = KS * 32, KSTR = DQK * 2 + 16, VSTR = 144, KBUF = 64 * KSTR, VBUF = 128 * VSTR;
    constexpr int KCH = DQK / 8;
    constexpr int KIT = (64 * KCH) / NT;
    TID_OPAQUE(tid); const int wave = __builtin_amdgcn_readfirstlane(tid >> 6), lane = tid & 63, fr = lane & 15, g = lane >> 4;
    const bool late = false;
    const int n_lat = NB * NH * 16, total = n_lat + NB * NH;
    LAS unsigned char* kb0 = lds; LAS unsigned char* vb0 = lds + 2 * KBUF;
#define AT_QK(kb_) do { constexpr int KPB = 4 / KS;     \
        bf16x8 fa_[4], fb_[4]; \
        _Pragma("unroll") for (int q_ = 0; q_ < 4; ++q_) fa_[q_] = *(const LAS bf16x8*)((kb_) + ((q_ / KS) * 16 + fr) * KSTR + (q_ % KS) * 64 + g * 16); \
        _Pragma("unroll") for (int kt = 0; kt < 4; kt += 2 * KPB) { \
            _Pragma("unroll") for (int q_ = 0; q_ < 4; ++q_) fb_[q_] = *(const LAS bf16x8*)((kb_) + ((kt + KPB + q_ / KS) * 16 + fr) * KSTR + (q_ % KS) * 64 + g * 16); \
            __builtin_amdgcn_sched_barrier(0); \
            _Pragma("unroll") for (int k_ = 0; k_ < KPB; ++k_) { s[kt + k_][0] = (f32x4){-mrun[0], -mrun[0], -mrun[0], -mrun[0]}; s[kt + k_][1] = (f32x4){-mrun[1], -mrun[1], -mrun[1], -mrun[1]}; \
                _Pragma("unroll") for (int ks = 0; ks < KS; ++ks) { s[kt + k_][0] = __builtin_amdgcn_mfma_f32_16x16x32_bf16(fa_[k_ * KS + ks], qf[0][ks], s[kt + k_][0], 0, 0, 0); \
                    s[kt + k_][1] = __builtin_amdgcn_mfma_f32_16x16x32_bf16(fa_[k_ * KS + ks], qf[1][ks], s[kt + k_][1], 0, 0, 0); } } \
            __builtin_amdgcn_sched_barrier(0); \
            if (kt + 2 * KPB < 4) { _Pragma("unroll") for (int q_ = 0; q_ < 4; ++q_) fa_[q_] = *(const LAS bf16x8*)((kb_) + ((kt + 2 * KPB + q_ / KS) * 16 + fr) * KSTR + (q_ % KS) * 64 + g * 16); } \
            __builtin_amdgcn_sched_barrier(0); \
            _Pragma("unroll") for (int k_ = 0; k_ < KPB; ++k_) { s[kt + KPB + k_][0] = (f32x4){-mrun[0], -mrun[0], -mrun[0], -mrun[0]}; s[kt + KPB + k_][1] = (f32x4){-mrun[1], -mrun[1], -mrun[1], -mrun[1]}; \
                _Pragma("unroll") for (int ks = 0; ks < KS; ++ks) { s[kt + KPB + k_][0] = __builtin_amdgcn_mfma_f32_16x16x32_bf16(fb_[k_ * KS + ks], qf[0][ks], s[kt + KPB + k_][0], 0, 0, 0); \
                    s[kt + KPB + k_][1] = __builtin_amdgcn_mfma_f32_16x16x32_bf16(fb_[k_ * KS + ks], qf[1][ks], s[kt + KPB + k_][1], 0, 0, 0); } } \
            __builtin_amdgcn_sched_barrier(0); } } while (0)
#define AT_SM(force_) do { _Pragma("unroll") for (int qt = 0; qt < 2; ++qt) {   \
        float mx = s[0][qt][0]; \
        _Pragma("unroll") for (int kt = 0; kt < 4; ++kt) _Pragma("unroll") for (int j = 0; j < 4; ++j) mx = fmaxf(mx, s[kt][qt][j]); \
        if ((force_) || __any(mx > 8.0f)) {   \
            mx = fmaxf(mx, __shfl_xor(mx, 16)); mx = fmaxf(mx, __shfl_xor(mx, 32)); \
            const float dm = (force_) ? mx : fmaxf(mx, 0.f), alpha = (force_) ? 1.0f : __builtin_amdgcn_exp2f(-dm);     \
            mrun[qt] += dm; lsum[qt] *= alpha; \
            _Pragma("unroll") for (int dt = 0; dt < 8; ++dt) oacc[dt][qt] = oacc[dt][qt] * alpha; \
            _Pragma("unroll") for (int kt = 0; kt < 4; ++kt) s[kt][qt] = s[kt][qt] - dm; } \
        float ps = 0.f; float pv[4][4]; \
        _Pragma("unroll") for (int kt = 0; kt < 4; ++kt) _Pragma("unroll") for (int j = 0; j < 4; ++j) { pv[kt][j] = __builtin_amdgcn_exp2f(s[kt][qt][j]); ps += pv[kt][j]; } \
        lsum[qt] += ps; \
        _Pragma("unroll") for (int k2 = 0; k2 < 2; ++k2) { u32x4 w_; w_.x = pk_bf16(pv[2 * k2][0], pv[2 * k2][1]); w_.y = pk_bf16(pv[2 * k2][2], pv[2 * k2][3]); \
            w_.z = pk_bf16(pv[2 * k2 + 1][0], pv[2 * k2 + 1][1]); w_.w = pk_bf16(pv[2 * k2 + 1][2], pv[2 * k2 + 1][3]); pb[k2][qt] = __builtin_bit_cast(bf16x8, w_); } } } while (0)
#define AT_PV_PRE(vb_) do { _Pragma("unroll") for (int q_ = 0; q_ < 4; ++q_) va_[q_] = *(const LAS bf16x8*)((vb_) + ((q_ >> 1) * 16 + fr) * VSTR + (q_ & 1) * 64 + g * 16); } while (0)
#define AT_PV(vb_) do { bf16x8 vb2_[4];     \
        _Pragma("unroll") for (int dt = 0; dt < 8; dt += 4) { \
            _Pragma("unroll") for (int q_ = 0; q_ < 4; ++q_) vb2_[q_] = *(const LAS bf16x8*)((vb_) + ((dt + 2 + (q_ >> 1)) * 16 + fr) * VSTR + (q_ & 1) * 64 + g * 16); \
            __builtin_amdgcn_sched_barrier(0); \
            _Pragma("unroll") for (int q_ = 0; q_ < 4; ++q_) { oacc[dt + (q_ >> 1)][0] = __builtin_amdgcn_mfma_f32_16x16x32_bf16(va_[q_], pb[q_ & 1][0], oacc[dt + (q_ >> 1)][0], 0, 0, 0); \
                oacc[dt + (q_ >> 1)][1] = __builtin_amdgcn_mfma_f32_16x16x32_bf16(va_[q_], pb[q_ & 1][1], oacc[dt + (q_ >> 1)][1], 0, 0, 0); } \
            __builtin_amdgcn_sched_barrier(0); \
            if (dt + 4 < 8) { _Pragma("unroll") for (int q_ = 0; q_ < 4; ++q_) va_[q_] = *(const LAS bf16x8*)((vb_) + ((dt + 4 + (q_ >> 1)) * 16 + fr) * VSTR + (q_ & 1) * 64 + g * 16); } \
            __builtin_amdgcn_sched_barrier(0); \
            _Pragma("unroll") for (int q_ = 0; q_ < 4; ++q_) { oacc[dt + 2 + (q_ >> 1)][0] = __builtin_amdgcn_mfma_f32_16x16x32_bf16(vb2_[q_], pb[q_ & 1][0], oacc[dt + 2 + (q_ >> 1)][0], 0, 0, 0); \
                oacc[dt + 2 + (q_ >> 1)][1] = __builtin_amdgcn_mfma_f32_16x16x32_bf16(vb2_[q_], pb[q_ & 1][1], oacc[dt + 2 + (q_ >> 1)][1], 0, 0, 0); } \
            __builtin_amdgcn_sched_barrier(0); } } while (0)
#define AT_WRITE(kdst_, vdst_) do { _Pragma("unroll") for (int i = 0; i < KIT; ++i) { const int c = tid + NT * i; *(LAS u32x4*)((kdst_) + (c / KCH) * KSTR + (c % KCH) * 16) = kreg[i]; } \
        _Pragma("unroll") for (int i = 0; i < 2; ++i) { const int c = tid + NT * i, kc = c & 7, kk = kc & 3; const int d_ = c >> 3, rho_ = (((d_ >> 5) * 2 + ((d_ >> 2) & 1)) << 4) + (((d_ >> 3) & 3) << 2) + (d_ & 3);     \
            LAS unsigned char* vp = (vdst_) + rho_ * VSTR + (kc >> 2) * 64 + 32 * (kk & 1) + 8 * (kk >> 1); \
            *(LAS u32x2*)vp = (u32x2){vreg[i].x, vreg[i].y}; *(LAS u32x2*)(vp + 16) = (u32x2){vreg[i].z, vreg[i].w}; } } while (0)
    for (int it0 = blockIdx.x; it0 < total; it0 += gridDim.x) {
        int it = it0;
        if (gridDim.x == 256 && it0 < n_lat) { const int rnd = it0 >> 8, bi = it0 & 255, x = bi & 7, slot = bi >> 3; it = (rnd << 8) + ((((x << 1) + (slot >> 4))) << 4) + (slot & 15); }
        int b, hh, qoff, nk;
        if (it < n_lat) { const int qb = it & 15; hh = (it >> 4) % NH; b = (it >> 4) / NH; qoff = CTX + qb * 256; nk = TPB; }
        else { const int c = it - n_lat; hh = c % NH; b = c / NH; qoff = 0; nk = CTX; }
        const int ntile = nk / 64;
        const size_t qrow0 = (size_t)b * TPB + qoff + wave * 32;
        const int kcol0 = DA ? hh * 64 : (hh >> 2) * 128, vrow0 = DA ? (hh >> 1) * 128 : (hh >> 2) * 128;
        const u16* Kb = K + (size_t)b * TPB * ldk + kcol0; const u16* Vb = VT + ((size_t)b * vtr + vrow0) * TPB;
        bf16x8 qf[2][KS];
#pragma unroll
        for (int qt = 0; qt < 2; ++qt)
#pragma unroll
            for (int ks = 0; ks < KS; ++ks) qf[qt][ks] = *(const bf16x8*)(Q + (qrow0 + qt * 16 + fr) * 1024 + hh * DQK + ks * 32 + g * 8);
        f32x4 oacc[8][2];
#pragma unroll
        for (int dt = 0; dt < 8; ++dt) { oacc[dt][0] = (f32x4){0.f, 0.f, 0.f, 0.f}; oacc[dt][1] = (f32x4){0.f, 0.f, 0.f, 0.f}; }
        float mrun[2] = {0.f, 0.f}, lsum[2] = {0.f, 0.f};
        u32x4 kreg[KIT], vreg[2];
        f32x4 s[4][2]; bf16x8 pb[2][2];
#pragma unroll
        for (int i = 0; i < KIT; ++i) { const int c = tid + NT * i; kreg[i] = *(const u32x4*)(Kb + (size_t)(c / KCH) * ldk + (c % KCH) * 8); }
#pragma unroll
        for (int i = 0; i < 2; ++i) { const int c = tid + NT * i; vreg[i] = *(const u32x4*)(Vb + (size_t)(c >> 3) * TPB + (c & 7) * 8); }
        __syncthreads();
        AT_WRITE(kb0, vb0);
        __syncthreads();
        int vcur = 0, vprev = 2;
        for (int t = 0; t < ntile; ++t) {
            LAS unsigned char* kb = kb0 + (t & 1) * KBUF;
            const bool more = (t + 1 < ntile);
            if (more) {
                const u16* Kt = Kb + (size_t)(t + 1) * 64 * ldk; const u16* Vt = Vb + (t + 1) * 64;
#pragma unroll
                for (int i = 0; i < KIT; ++i) { const int c = tid + NT * i; kreg[i] = *(const u32x4*)(Kt + (size_t)(c / KCH) * ldk + (c % KCH) * 8); }
#pragma unroll
                for (int i = 0; i < 2; ++i) { const int c = tid + NT * i; vreg[i] = *(const u32x4*)(Vt + (size_t)(c >> 3) * TPB + (c & 7) * 8); }
            }
            AT_QK(kb);
            bf16x8 va_[4]; AT_PV_PRE(vb0 + vcur * VBUF);
            AT_SM(t == 0);
            const int vnext = (vcur == 2) ? 0 : vcur + 1;
            if (more) AT_WRITE(kb0 + ((t + 1) & 1) * KBUF, vb0 + vnext * VBUF);
            AT_PV(vb0 + vcur * VBUF);
            __syncthreads();
            vprev = vcur; vcur = vnext;
        }
#pragma unroll
        for (int qt = 0; qt < 2; ++qt) {
            float l = lsum[qt]; l += __shfl_xor(l, 16); l += __shfl_xor(l, 32); const float inv = 1.0f / l;
            u16* orow = O + (qrow0 + qt * 16 + fr) * ldo + hh * 128 + 8 * g;
#pragma unroll
            for (int m2 = 0; m2 < 4; ++m2) { const f32x4 o0 = oacc[2 * m2][qt] * inv, o1 = oacc[2 * m2 + 1][qt] * inv;
                u32x4 w; w.x = pk_bf16(o0[0], o0[1]); w.y = pk_bf16(o0[2], o0[3]); w.z = pk_bf16(o1[0], o1[1]); w.w = pk_bf16(o1[2], o1[3]); *(u32x4*)(orow + m2 * 32) = w; }
        }
    }
    __syncthreads();
#undef AT_QK
#undef AT_SM
#undef AT_PV
#undef AT_PV_PRE
#undef AT_WRITE
}

DI float dpp_red8(float x) {
    x += __builtin_bit_cast(float, __builtin_amdgcn_update_dpp(0, __builtin_bit_cast(int, x), 0xB1, 0xF, 0xF, true));
    x += __builtin_bit_cast(float, __builtin_amdgcn_update_dpp(0, __builtin_bit_cast(int, x), 0x4E, 0xF, 0xF, true));
    x += __builtin_bit_cast(float, __builtin_amdgcn_update_dpp(0, __builtin_bit_cast(int, x), 0x141, 0xF, 0xF, true));
    return x;
}
DI float dpp_red16(float x) {
    x = dpp_red8(x);
    x += __builtin_bit_cast(float, __builtin_amdgcn_update_dpp(0, __builtin_bit_cast(int, x), 0x140, 0xF, 0xF, true));
    return x;
}
constexpr int SCT = 32;
DI void phase_scan(LAS unsigned char* lds, PP p, const h16* R, const h16* Kx, const h16* V, h16* WP  , const h16* AA, bool do_store) {
    LAS float* LW = (LAS float*)lds; LAS float* LA = LW + SCT * 64; LAS float* LB = LA + SCT * 64; LAS float* LK = LB + SCT * 64; LAS float* LR = LK + SCT * 64; LAS float* LV = LR + SCT * 64; LAS float* LY = LV + SCT * 64;
    FRESH(p); TID_OPAQUE(tid); const int wave = tid >> 6, lane = tid & 63, row = tid >> 3, ks = tid & 7;
    for (int item0 = blockIdx.x; item0 < NB * 16 * 2; item0 += gridDim.x) {
        const int item = (gridDim.x == 256) ? ((item0 & 7) << 5) + (item0 >> 3) : item0;
        const int dir = item & 1, h = (item >> 1) & 15, b = item >> 5;
        const float kkc = p->in[30][dir * 1024 + h * 64 + lane], kac = p->in[31][dir * 1024 + h * 64 + lane];
        const size_t cshared = (size_t)h * 64 + lane, cdir = (size_t)dir * 1024 + h * 64 + lane;
        const int roc = dir * 1024 + h * 64 + (tid & 15) * 4;
        const f32x4 ro_rk = *(const f32x4*)(p->in[32] + roc), ro_g = *(const f32x4*)(p->in[33] + roc), ro_b = *(const f32x4*)(p->in[34] + roc);
        f32x2 S[4];
#pragma unroll
        for (int j = 0; j < 4; ++j) S[j] = (f32x2){0.f, 0.f};
        h16 pr[4], pk[4], pv[4], pw[4], pa[4];
#define SCAN_ROW(n) ((size_t)b * TPB + (dir == 0 ? (n) : ((n) < CTX ? (CTX - 1 - (n)) : (TPB + CTX - 1 - (n)))))
#define SCAN_LOAD(c) do { _Pragma("unroll") for (int i = 0; i < 4; ++i) { const size_t rr = SCAN_ROW((c) * SCT + wave * 4 + i); \
        pr[i] = R[rr * 1024 + cshared]; pk[i] = Kx[rr * 1024 + cshared]; pv[i] = V[rr * 1024 + cshared]; pw[i] = WP[rr * 2048 + cdir]; pa[i] = AA[rr * 2048 + cdir]; } } while (0)
        SCAN_LOAD(0);
        for (int c = 0; c < TPB / SCT; ++c) {
#pragma unroll
            for (int i = 0; i < 4; ++i) { const int st = wave * 4 + i; const float r = (float)pr[i], k = (float)pk[i], v = (float)pv[i], wp = (float)pw[i], a = (float)pa[i];
                const float dec = __expf(-0.60653065971263342f * __builtin_amdgcn_rcpf(1.0f + __expf(-wp)));
                float kk = k * kkc; float ssq = dpp_red16(kk * kk); ssq += __shfl_xor(ssq, 16); ssq += __shfl_xor(ssq, 32);
                kk = kk * __builtin_amdgcn_rsqf(fmaxf(ssq, 1e-24f));
                const float kd = k * (1.0f + (a - 1.0f) * kac);
                LW[st * 64 + lane] = dec; LA[st * 64 + lane] = -kk; LB[st * 64 + lane] = kk * a; LK[st * 64 + lane] = kd; LR[st * 64 + lane] = r; LV[st * 64 + lane] = v; }
            __syncthreads();
            if (c + 1 < TPB / SCT) SCAN_LOAD(c + 1);
#define SC_LOAD(P, st_) do { const int o_ = (st_) * 64 + ks * 8; \
                P##a0 = *(const LAS f32x4*)(LA + o_); P##a1 = *(const LAS f32x4*)(LA + o_ + 4); P##w0 = *(const LAS f32x4*)(LW + o_); P##w1 = *(const LAS f32x4*)(LW + o_ + 4); \
                P##b0 = *(const LAS f32x4*)(LB + o_); P##b1 = *(const LAS f32x4*)(LB + o_ + 4); P##k0 = *(const LAS f32x4*)(LK + o_); P##k1 = *(const LAS f32x4*)(LK + o_ + 4); \
                P##r0 = *(const LAS f32x4*)(LR + o_); P##r1 = *(const LAS f32x4*)(LR + o_ + 4); P##vv = LV[(st_) * 64 + row]; } while (0)
#define SC_STEP(P, st_) do { \
                const f32x2 t0_ = S[0] * (f32x2){P##a0[0], P##a0[1]} + S[1] * (f32x2){P##a0[2], P##a0[3]}; \
                const f32x2 t1_ = S[2] * (f32x2){P##a1[0], P##a1[1]} + S[3] * (f32x2){P##a1[2], P##a1[3]}; const f32x2 t_ = t0_ + t1_; \
                const float sa = dpp_red8(t_[0] + t_[1]); const f32x2 sa2 = {sa, sa}, v2 = {P##vv, P##vv}; \
                S[0] = S[0] * (f32x2){P##w0[0], P##w0[1]} + (sa2 * (f32x2){P##b0[0], P##b0[1]} + v2 * (f32x2){P##k0[0], P##k0[1]}); \
                S[1] = S[1] * (f32x2){P##w0[2], P##w0[3]} + (sa2 * (f32x2){P##b0[2], P##b0[3]} + v2 * (f32x2){P##k0[2], P##k0[3]}); \
                S[2] = S[2] * (f32x2){P##w1[0], P##w1[1]} + (sa2 * (f32x2){P##b1[0], P##b1[1]} + v2 * (f32x2){P##k1[0], P##k1[1]}); \
                S[3] = S[3] * (f32x2){P##w1[2], P##w1[3]} + (sa2 * (f32x2){P##b1[2], P##b1[3]} + v2 * (f32x2){P##k1[2], P##k1[3]}); \
                const f32x2 y0_ = S[0] * (f32x2){P##r0[0], P##r0[1]} + S[1] * (f32x2){P##r0[2], P##r0[3]}; \
                const f32x2 y1_ = S[2] * (f32x2){P##r1[0], P##r1[1]} + S[3] * (f32x2){P##r1[2], P##r1[3]}; const f32x2 y_ = y0_ + y1_; \
                const float ys = dpp_red8(y_[0] + y_[1]); if (ks == 0) LY[(st_) * 64 + row] = ys; } while (0)
            { f32x4 Aa0, Aa1, Aw0, Aw1, Ab0, Ab1, Ak0, Ak1, Ar0, Ar1, Ba0, Ba1, Bw0, Bw1, Bb0, Bb1, Bk0, Bk1, Br0, Br1; float Avv, Bvv;
              SC_LOAD(A, 0);
#pragma unroll 2
              for (int st = 0; st < SCT; st += 2) {
                  SC_LOAD(B, st + 1);
                  SC_STEP(A, st);
                  if (st + 2 < SCT) SC_LOAD(A, st + 2);
                  SC_STEP(B, st + 1);
              } }
#undef SC_LOAD
#undef SC_STEP
            __syncthreads();
            { const int st = tid >> 4, e0 = (tid & 15) * 4; const size_t rr = SCAN_ROW(c * SCT + st);
              const f32x4 yv = *(const LAS f32x4*)(LY + st * 64 + e0), rv = *(const LAS f32x4*)(LR + st * 64 + e0), kv = *(const LAS f32x4*)(LK + st * 64 + e0), vv4 = *(const LAS f32x4*)(LV + st * 64 + e0);
              const float mean = dpp_red16((yv[0] + yv[1]) + (yv[2] + yv[3])) * (1.0f / 64.0f); const f32x4 dy = yv - mean;
              const float var = dpp_red16((dy[0] * dy[0] + dy[1] * dy[1]) + (dy[2] * dy[2] + dy[3] * dy[3])) * (1.0f / 64.0f);
              const f32x4 rkk = rv * kv * ro_rk; const float bs = dpp_red16((rkk[0] + rkk[1]) + (rkk[2] + rkk[3]));
              const float rstd = 1.0f / sqrtf(var + 64e-5f);
              const f32x4 o = dy * rstd * ro_g + ro_b + vv4 * bs;
              h16x4 hv; hv[0] = (h16)o[0]; hv[1] = (h16)o[1]; hv[2] = (h16)o[2]; hv[3] = (h16)o[3];
              if (do_store) *(h16x4*)(WP + rr * 2048 + (size_t)dir * 1024 + h * 64 + e0) = hv; }
        }
        __syncthreads();
#undef SCAN_LOAD
#undef SCAN_ROW
    }
}
DI void phase0(LAS unsigned char* lds, PP p) {
    FRESH(p); TID_OPAQUE(tid); const size_t gt = (size_t)blockIdx.x * NT + tid, GT = (size_t)gridDim.x * NT;
    { const f32x4* x4 = (const f32x4*)p->in[0]; f32x4* o4 = (f32x4*)p->out; for (size_t i = gt; i < (size_t)NB * SEQ * D / 4; i += GT) o4[i] = x4[i];
      const f32x4* c4 = (const f32x4*)p->in[2]; f32x4* h4 = (f32x4*)(p->ws + OFF_HC); for (size_t i = gt; i < (size_t)NB * CTX * D / 4; i += GT) h4[i] = c4[i]; }
    { float* tda = (float*)(p->ws + OFF_ROPE_DA); for (size_t i = gt; i < (size_t)SEQ * 32; i += GT) { const int sp = (int)(i >> 5), jj = (int)(i & 31), f = jj & 15; const float pos = (float)(jj < 16 ? sp / 64 : sp % 64);
          const float inv = powf(10000.0f, -(float)f / 16.0f), ang = pos * inv; tda[2 * i] = cosf(ang); tda[2 * i + 1] = sinf(ang); }
      float* tgq = (float*)(p->ws + OFF_ROPE_GQ); for (size_t i = gt; i < (size_t)SEQ * 64; i += GT) { const int sp = (int)(i >> 6), jj = (int)(i & 63), f = jj & 31; const float pos = (float)(jj < 32 ? sp / 64 : sp % 64);
          const float inv = powf(10000.0f, -(float)f / 32.0f), ang = pos * inv; tgq[2 * i] = cosf(ang); tgq[2 * i + 1] = sinf(ang); } }
    LAS float* act = (LAS float*)lds;
    float* modp = (float*)(p->ws + OFF_ARENA);
    for (int item = blockIdx.x; item < 4 * 18 * 4; item += gridDim.x) {
        const int ksx = item & 3, cb = (item >> 2) % 18, layer = (item >> 2) / 18, k0 = ksx * 256;
        __syncthreads();
        for (int idx = tid; idx < 256 * 9; idx += NT) { const int k = idx / 9, r = idx % 9; const float cv = r < 8 ? p->in[1][r * 1024 + k0 + k] : p->in[3][k0 + k]; act[k * 12 + r] = cv * sigmoidf_(cv); }
        __syncthreads();
        const int col = cb * 512 + tid; const float* W = p->in[4] + ((size_t)layer * 1024 + k0) * 9216 + col;
        f32x4 a0 = {0.f, 0.f, 0.f, 0.f}, a1 = {0.f, 0.f, 0.f, 0.f}; float a8 = 0.f;
#pragma unroll 8
        for (int k = 0; k < 256; ++k) { const float w = W[(size_t)k * 9216]; a0 += *(const LAS f32x4*)(act + k * 12) * w; a1 += *(const LAS f32x4*)(act + k * 12 + 4) * w; a8 += act[k * 12 + 8] * w; }
        float* dst = modp + ((size_t)(ksx * 4 + layer) * 9) * 9216 + col;
        dst[0] = a0[0]; dst[9216] = a0[1]; dst[2 * 9216] = a0[2]; dst[3 * 9216] = a0[3]; dst[4 * 9216] = a1[0]; dst[5 * 9216] = a1[1]; dst[6 * 9216] = a1[2]; dst[7 * 9216] = a1[3]; dst[8 * 9216] = a8;
    }
    __syncthreads();
}
DI void phase0b(PP p) {
    FRESH(p); TID_OPAQUE(tid); const size_t gt = (size_t)blockIdx.x * NT + tid, GT = (size_t)gridDim.x * NT; const size_t n = (size_t)4 * 9 * 9216;
    const float* modp = (const float*)(p->ws + OFF_ARENA); float* mods = (float*)(p->ws + OFF_MODS);
    for (size_t i = gt; i < n; i += GT) { const int layer = (int)(i / (9 * 9216)), col = (int)(i % 9216); mods[i] = ((modp[i] + modp[n + i]) + (modp[2 * n + i] + modp[3 * n + i])) + p->in[5][layer * 9216 + col]; }
}


DI void gbar(unsigned* ctr, unsigned& target) {
    asm volatile("s_waitcnt vmcnt(0)" ::: "memory");
    __syncthreads();
    target += gridDim.x;
    if (threadIdx.x == 0) {
        __builtin_amdgcn_fence(__ATOMIC_RELEASE, "agent");
        asm volatile("s_waitcnt vmcnt(0)" ::: "memory");
        __hip_atomic_fetch_add(ctr, 1u, __ATOMIC_RELAXED, __HIP_MEMORY_SCOPE_AGENT);
        while (__hip_atomic_load(ctr, __ATOMIC_RELAXED, __HIP_MEMORY_SCOPE_AGENT) < target) __builtin_amdgcn_s_sleep(1);
        __builtin_amdgcn_fence(__ATOMIC_ACQUIRE, "agent");
        asm volatile("s_waitcnt vmcnt(0)" ::: "memory");
    }
    __syncthreads();
}
#define GSYNC() gbar((unsigned*)WSP(OFF_BAR), bar_target)
#ifndef REP_ATT
#define REP_ATT 1
#endif
#ifndef REP_SCAN
#define REP_SCAN 1
#endif
#ifndef REP_FFN
#define REP_FFN 1
#endif
#ifndef REP_P0
#define REP_P0 1
#endif
#ifndef REP_MIX
#define REP_MIX 1
#endif
#ifndef REP_MISC
#define REP_MISC 1
#endif
#define WSP(off) (kp_fresh(kp)->ws + (off))
#define SLABP(i) ((u16*)(kp_fresh(kp)->ws + OFF_ARENA + (size_t)(i) * SLAB))
DI PP kp_fresh(PP q) { FRESH(q); return q; }
DI EpiRes make_res(PP kp, int layer, int gidx, float coef) { PP q = kp_fresh(kp); EpiRes e; e.out = q->out; e.hc = (float*)(q->ws + OFF_HC); e.modl = (const float*)(q->ws + OFF_MODS) + (size_t)layer * 9 * 9216; e.gidx = gidx; e.coef = coef; return e; }
__global__ void __launch_bounds__(512, 2) mega_fwd(Params p_unused) {
    extern __shared__ __attribute__((aligned(16))) unsigned char shm[];
    LAS unsigned char* lds = (LAS unsigned char*)shm;
    cg::grid_group grid = cg::this_grid();
    PP kp = (PP)__builtin_amdgcn_kernarg_segment_ptr();
    unsigned bar_target = 0;

    for (int rep = 0; rep < REP_P0; ++rep) phase0(lds, kp);
    __threadfence(); grid.sync();
    if (PM & 1) phase0b(kp);
    GSYNC();

    for (int layer = 0; layer < 4; ++layer) {
        const int kind = layer % 3, jm = layer / 3;
        for (int sub = 0; sub < 3; ++sub) {
            if (sub != 1) {
                const int which = sub == 0 ? 0 : 1;
                for (int rep = 0; rep < REP_MISC; ++rep) { int tb = 0; conv_ffn(lds, kp, layer, which, tb); if (sub == 0) conv_mixer(lds, kp, layer, tb); }
                for (int rep = 0; rep < REP_MISC; ++rep) phase_modulate(kp, layer, sub == 0 ? 0 : 6, sub == 0 ? 1 : 7, SLABP(0));
                GSYNC();
                for (int rep = 0; rep < REP_FFN; ++rep) { EpiFfn1 e; e.H = SLABP(1); run_gemm(lds, SLABP(0), (const u16*)WSP(OFF_W1T), 5632, 1024, e, layer == 3 && sub == 2); }
                GSYNC();
                for (int rep = 0; rep < REP_FFN; ++rep) { const EpiRes e = make_res(kp, layer, sub == 0 ? 2 : 8, rep == 0 ? 0.5f : 0.0f); run_gemm(lds, SLABP(1), (const u16*)WSP(OFF_W2T), 1024, 2816, e, layer == 3 && sub == 2); }
                GSYNC();
            } else {
                int ao_slab;
                if (kind == 0) {
                    for (int rep = 0; rep < REP_MIX; ++rep) phase_modulate(kp, layer, 3, 4, SLABP(0));
                    GSYNC();
                    for (int rep = 0; rep < REP_MIX; ++rep) { EpiDaQkv e; e.ar = WSP(OFF_ARENA); e.tab = (const float*)WSP(OFF_ROPE_DA); run_gemm(lds, SLABP(0), (const u16*)WSP(OFF_WMIX + WM_QKV), 3072, 1024, e); }
                    GSYNC();
                    for (int rep = 0; rep < REP_MIX; ++rep) transpose_v(lds, SLABP(1), 1024, SLABP(4));
                    GSYNC();
                    for (int rep = 0; rep < REP_ATT; ++rep) attn_phase<2, true>(lds, SLABP(2), SLABP(3), 1024, SLABP(4), 1024, SLABP(0), 2048, 16);
                    GSYNC();
                    for (int rep = 0; rep < REP_MIX; ++rep) combine_da(kp, jm, layer, SLABP(0), SLABP(2));
                    GSYNC();
                    ao_slab = 2;
                } else if (kind == 1) {
                    for (int rep = 0; rep < REP_MIX; ++rep) phase_modulate(kp, layer, 3, 4, SLABP(0));
                    GSYNC();
                    for (int rep = 0; rep < REP_MIX; ++rep) { EpiStore16<1> e; e.ar = WSP(OFF_ARENA); e.col_base = 0; run_gemm(lds, SLABP(0), (const u16*)WSP(OFF_WMIX + WM_QKV), 1536, 1024, e); }
                    GSYNC();
                    qknorm_rope_gq(kp, SLABP(2), SLABP(3)); for (int rep = 0; rep < REP_MIX; ++rep) transpose_v(lds, SLABP(1), 256, SLABP(4));
                    GSYNC();
                    for (int rep = 0; rep < REP_ATT; ++rep) attn_phase<4, false>(lds, SLABP(2), SLABP(3), 256, SLABP(4), 256, SLABP(0), 1024, 8);
                    GSYNC();
                    ao_slab = 0;
                } else {
                    phase_modulate(kp, layer, 3, 4, SLABP(3));
                    GSYNC();
                    phase_mix(kp, SLABP(3), SLABP(0), SLABP(1), SLABP(2), 0, 2, 3);
                    GSYNC();
                    { EpiStore16<2> e; e.ar = WSP(OFF_ARENA); e.col_base = 0; run_gemm(lds, SLABP(0), (const u16*)WSP(OFF_WMIX + WM_QKV), 3072, 1024, e, 0, 2, SLAB); }
                    GSYNC();
                    phase_mix(kp, SLABP(3), SLABP(0), SLABP(1), SLABP(2), 1, 4, 5);
                    GSYNC();
                    { EpiStore16<2> e; e.ar = WSP(OFF_ARENA); e.col_base = 3072; run_gemm(lds, SLABP(0), (const u16*)WSP(OFF_WMIX + WM_QKV) + (size_t)3072 * 1024, 768, 1024, e, 0, 0, SLAB); }
                    GSYNC();
                    for (int rep = 0; rep < REP_MIX; ++rep) { EpiRw2<0> e; e.O = (h16*)SLABP(0); e.bias = kp_fresh(kp)->in[22]; run_gemm(lds, SLABP(7), (const u16*)WSP(OFF_WMIX + WM_RW_W2), 2048, 256, e); }
                    for (int rep = 0; rep < REP_MIX; ++rep) { EpiRw2<1> e; e.O = (h16*)SLABP(2); e.bias = kp_fresh(kp)->in[25]; run_gemm(lds, SLABP(7) + (size_t)M * 256, (const u16*)WSP(OFF_WMIX + WM_RW_A2), 2048, 256, e); }
                    GSYNC();
                    for (int rep = 0; rep < REP_SCAN; ++rep) phase_scan(lds, kp, (const h16*)SLABP(4), (const h16*)SLABP(5), (const h16*)SLABP(6), (h16*)SLABP(0), (const h16*)SLABP(2), rep == REP_SCAN - 1);
                    GSYNC();
                    for (int rep = 0; rep < REP_MIX; ++rep) { EpiRw3 e; e.T = (const h16*)SLABP(0); e.O = SLABP(4); run_gemm(lds, SLABP(7) + (size_t)M * 512, (const u16*)WSP(OFF_WMIX + WM_RW_G2), 2048, 256, e); }
                    GSYNC();
                    ao_slab = 4;
                }
                for (int rep = 0; rep < REP_MIX; ++rep) { const EpiRes e = make_res(kp, layer, 5, rep == 0 ? 1.0f : 0.0f); run_gemm(lds, SLABP(ao_slab), (const u16*)WSP(OFF_WMIX + WM_WO), 1024, 1024, e, layer == 3); }
                GSYNC();
            }
        }
    }
    if (PM & 65536) phase_final(kp);
}

extern "C" void kernel_launch(void* const* d_in, const int* in_sizes, int n_in, void* d_out, int out_size, void* d_ws, size_t ws_size, hipStream_t stream) {
    constexpr size_t kDynLds = 131072;
    static int grid_blocks = 0;
    if (!grid_blocks) {
        int dev = 0, cus = 0, per_cu = 0;
        hipGetDevice(&dev);
        hipDeviceGetAttribute(&cus, hipDeviceAttributeMultiprocessorCount, dev);
        hipFuncSetAttribute((const void*)mega_fwd, hipFuncAttributeMaxDynamicSharedMemorySize, (int)kDynLds);
        hipOccupancyMaxActiveBlocksPerMultiprocessor(&per_cu, (const void*)mega_fwd, NT, kDynLds);
        if (per_cu < 1) per_cu = 1;
        grid_blocks = cus * per_cu;
        if (n_in != 35 || ws_size < WS_NEED) { fprintf(stderr, "kernel_launch: unexpected n_in %d or ws_size %zu < %zu\n", n_in, ws_size, (size_t)WS_NEED); grid_blocks = -1; }
    }
    if (grid_blocks < 0) return;
    Params p{};
    for (int i = 0; i < 35; ++i) p.in[i] = (const float*)d_in[i];
    p.out = (float*)d_out; p.ws = (unsigned char*)d_ws; p.ws_size = ws_size;
    hipMemsetAsync((char*)d_ws + OFF_BAR, 0, 256, stream);
    void* args[] = {&p};
    hipError_t e = hipLaunchCooperativeKernel((void*)mega_fwd, dim3(grid_blocks), dim3(NT), args, kDynLds, stream);
    if (e != hipSuccess) fprintf(stderr, "cooperative launch failed: %s (grid %d)\n", hipGetErrorString(e), grid_blocks);
}
```
